# Optimizing an MI355X kernel written in HIP

```python
import math
import jax, jax.numpy as jnp
from jax import lax
import numpy as np

D_MODEL = 1024
BATCH = 8
SEQ = 4096
DEPTH = 1

CHUNK = 64
SB_HEADS = 8
SB_HEAD_DIM = D_MODEL // 16
SB_WIDTH = SB_HEADS * SB_HEAD_DIM
CA_HEADS = 8
CA_HEAD_DIM = D_MODEL // 16
CA_WIDTH = CA_HEADS * CA_HEAD_DIM
CA_PREV_CHUNKS = 8
CA_BAND = (CA_PREV_CHUNKS + 1) * CHUNK
REL_CLIP = 256
Q_BLOCK = 128
D_FF = 4 * D_MODEL
DEEPNORM_ALPHA = (2.0 * DEPTH) ** 0.25
DEEPNORM_BETA = (8.0 * DEPTH) ** -0.25
LN_EPS = 1e-5
IN_COLS = 3 * SB_WIDTH + 3 * CA_WIDTH + 2 * D_MODEL

kernel_name = "hybrid_stickbreak_chunkrel_deepnorm"


def _layer_norm(x, g, b):
    xf = x.astype(jnp.float32)
    mu = jnp.mean(xf, axis=-1, keepdims=True)
    var = jnp.mean(jnp.square(xf - mu), axis=-1, keepdims=True)
    y = (xf - mu) * lax.rsqrt(var + LN_EPS) * g.astype(jnp.float32) + b.astype(jnp.float32)
    return y.astype(x.dtype)


def _stick_breaking(q, k, v):
    b, s_len, h, dh = q.shape
    scale = dh ** -0.5
    qh = q.transpose(0, 2, 1, 3)
    kh = k.transpose(0, 2, 1, 3)
    vh = v.transpose(0, 2, 1, 3).astype(jnp.float32)
    outs = []
    for i in range(s_len // Q_BLOCK):
        start = i * Q_BLOCK
        end = start + Q_BLOCK
        z = jnp.einsum('bhqd,bhkd->bhqk', qh[:, :, start:end], kh[:, :, :end],
                       preferred_element_type=jnp.float32) * scale
        t_pos = start + jnp.arange(Q_BLOCK)[:, None]
        s_pos = jnp.arange(end)[None, :]
        strict = s_pos < t_pos
        log_keep = jnp.where(strict, jax.nn.log_sigmoid(-z), 0.0)
        between = lax.cumsum(log_keep, axis=3, reverse=True) - log_keep
        a = jnp.where(strict, jnp.exp(jax.nn.log_sigmoid(z) + between), 0.0)
        outs.append(jnp.einsum('bhqk,bhkd->bqhd', a, vh[:, :, :end]))
    o = jnp.concatenate(outs, axis=1)
    return o.reshape(b, s_len, h * dh).astype(q.dtype)


def _rel_index():
    i = np.arange(CHUNK)[:, None]
    kk = np.arange(CA_BAND)[None, :]
    dist = (CA_PREV_CHUNKS - kk // CHUNK) * CHUNK + i - kk % CHUNK
    return np.clip(dist, -REL_CLIP, REL_CLIP) + REL_CLIP


def _chunk_attention(q, k, v, rel_bias):
    b, s_len, h, dh = q.shape
    n_chunks = s_len // CHUNK
    scale = dh ** -0.5
    pad = ((0, 0), (CA_PREV_CHUNKS, 0), (0, 0), (0, 0), (0, 0))
    qc = q.reshape(b, n_chunks, CHUNK, h, dh)
    kc = jnp.pad(k.reshape(b, n_chunks, CHUNK, h, dh), pad)
    vc = jnp.pad(v.reshape(b, n_chunks, CHUNK, h, dh), pad)
    band = jnp.arange(n_chunks)[:, None] + jnp.arange(CA_PREV_CHUNKS + 1)[None, :]
    kb = kc[:, band].reshape(b, n_chunks, CA_BAND, h, dh)
    vb = vc[:, band].reshape(b, n_chunks, CA_BAND, h, dh).astype(jnp.float32)
    scores = jnp.einsum('bcqhd,bckhd->bhcqk', qc, kb,
                        preferred_element_type=jnp.float32) * scale
    bias = rel_bias.astype(jnp.float32)[:, _rel_index()]
    valid = jnp.repeat(band >= CA_PREV_CHUNKS, CHUNK, axis=1)
    scores = jnp.where(valid[None, None, :, None, :], scores + bias[:, None], -jnp.inf)
    p = jax.nn.softmax(scores, axis=-1)
    o = jnp.einsum('bhcqk,bckhd->bcqhd', p, vb)
    return o.reshape(b, s_len, h * dh).astype(q.dtype)


def setup_inputs(seed: int = 0) -> dict:
    key = jax.random.key(seed)
    ks = jax.random.split(key, 13)
    beta = DEEPNORM_BETA
    x = jax.random.normal(ks[0], (BATCH, SEQ, D_MODEL), jnp.float32)
    col_scale = jnp.concatenate([
        jnp.ones((2 * SB_WIDTH,), jnp.float32), jnp.full((SB_WIDTH,), beta, jnp.float32),
        jnp.ones((2 * CA_WIDTH,), jnp.float32), jnp.full((CA_WIDTH,), beta, jnp.float32),
        jnp.ones((2 * D_MODEL,), jnp.float32)])
    w_in = jax.random.normal(ks[1], (D_MODEL, IN_COLS), jnp.float32) * D_MODEL ** -0.5 * col_scale
    b_gate = 0.1 * jax.random.normal(ks[2], (2 * D_MODEL,), jnp.float32)
    w_sb_proj = jax.random.normal(ks[3], (SB_WIDTH, D_MODEL), jnp.float32) * SB_WIDTH ** -0.5 * beta
    w_ca_proj = jax.random.normal(ks[4], (CA_WIDTH, D_MODEL), jnp.float32) * CA_WIDTH ** -0.5 * beta
    rel_bias = 0.2 * jax.random.normal(ks[5], (CA_HEADS, 2 * REL_CLIP + 1), jnp.float32)
    w_out = jax.random.normal(ks[6], (D_MODEL, D_MODEL), jnp.float32) * D_MODEL ** -0.5 * beta
    ln1_g = 1.0 + 0.02 * jax.random.normal(ks[7], (D_MODEL,), jnp.float32)
    ln1_b = 0.02 * jax.random.normal(ks[8], (D_MODEL,), jnp.float32)
    w_mlp_in = jax.random.normal(ks[9], (D_MODEL, D_FF), jnp.float32) * D_MODEL ** -0.5 * beta
    w_mlp_out = jax.random.normal(ks[10], (D_FF, D_MODEL), jnp.float32) * D_FF ** -0.5 * beta
    ln2_g = 1.0 + 0.02 * jax.random.normal(ks[11], (D_MODEL,), jnp.float32)
    ln2_b = 0.02 * jax.random.normal(ks[12], (D_MODEL,), jnp.float32)
    return {"x": x, "w_in": w_in, "b_gate": b_gate, "w_sb_proj": w_sb_proj,
            "w_ca_proj": w_ca_proj, "rel_bias": rel_bias, "w_out": w_out,
            "ln1_g": ln1_g, "ln1_b": ln1_b, "w_mlp_in": w_mlp_in, "w_mlp_out": w_mlp_out,
            "ln2_g": ln2_g, "ln2_b": ln2_b}


def reference(x, w_in, b_gate, w_sb_proj, w_ca_proj, rel_bias, w_out,
              ln1_g, ln1_b, w_mlp_in, w_mlp_out, ln2_g, ln2_b):
    b, s_len, _ = x.shape
    for _layer in range(DEPTH):
        h = x @ w_in
        o = 0
        q_sb = h[..., o:o + SB_WIDTH]; o += SB_WIDTH
        k_sb = h[..., o:o + SB_WIDTH]; o += SB_WIDTH
        v_sb = h[..., o:o + SB_WIDTH]; o += SB_WIDTH
        q_ca = h[..., o:o + CA_WIDTH]; o += CA_WIDTH
        k_ca = h[..., o:o + CA_WIDTH]; o += CA_WIDTH
        v_ca = h[..., o:o + CA_WIDTH]; o += CA_WIDTH
        gate_logits = h[..., o:o + 2 * D_MODEL] + b_gate
        sb_shape = (b, s_len, SB_HEADS, SB_HEAD_DIM)
        ca_shape = (b, s_len, CA_HEADS, CA_HEAD_DIM)
        y_sb = _stick_breaking(q_sb.reshape(sb_shape), k_sb.reshape(sb_shape),
                               v_sb.reshape(sb_shape)) @ w_sb_proj
        y_ca = _chunk_attention(q_ca.reshape(ca_shape), k_ca.reshape(ca_shape),
                                v_ca.reshape(ca_shape), rel_bias) @ w_ca_proj
        gates = jax.nn.sigmoid(gate_logits.astype(jnp.float32))
        merged = (gates[..., :D_MODEL] * y_sb + gates[..., D_MODEL:] * y_ca).astype(x.dtype)
        x = _layer_norm(DEEPNORM_ALPHA * x + merged @ w_out, ln1_g, ln1_b)
        ff = jnp.square(jax.nn.relu(x @ w_mlp_in)) @ w_mlp_out
        x = _layer_norm(DEEPNORM_ALPHA * x + ff, ln2_g, ln2_b)
    return x
```

```cpp
#include <hip/hip_runtime.h>
#include <hip/hip_cooperative_groups.h>
#include <cstdio>
#include <cstdint>
namespace cg = cooperative_groups;
constexpr int MTOK = 32768, DMODEL = 1024, SEQL = 4096, NBATCH = 8, NHEADS = 8, WIDTH = 512, DFF = 4096, NINC = 5120;
namespace pg8 {
#define PG8_LAS __attribute__((address_space(3)))
typedef unsigned short bf16_t;
typedef short bf16x8 __attribute__((ext_vector_type(8)));
typedef float f32x4 __attribute__((ext_vector_type(4)));
typedef unsigned u32x4 __attribute__((ext_vector_type(4)));
constexpr int BM = 256, BK = 64, HALF = 128, HTB = HALF * BK * 2  , STAGE_BYTES = 8 * HTB, NXCD = 8, WGM = 8;

__host__ __device__ __forceinline__ int lds_byte(int r, int c) { const int st = (r >> 4) * 2 + (c >> 5), rr = r & 15, cc = c & 31, ob = rr * 64 + cc * 2; return st * 1024 + (ob ^ (((ob >> 9) & 1) << 5)); }
__host__ __device__ __forceinline__ void stage_rc(int b, int& R, int& C) { const int st = b / 1024, sb = b % 1024, swz = sb ^ (((sb >> 9) & 1) << 5); R = (st >> 1) * 16 + swz / 64; C = (st & 1) * 32 + (swz % 64) / 2; }
__host__ __device__ __forceinline__ int perm32(int rho) { const int n = rho >> 4, i = rho & 15; return 8 * (i >> 2) + 4 * n + (i & 3); }

struct Unit { int pm, pn; };
struct Gemm { const bf16_t* A; const bf16_t* Bt; int M, N, K; };

struct StaticOrder {
    int nM, nN, nwg, G, c;
    __host__ __device__ void init(int M, int N, int G_, int c_) { nM = M / BM; nN = N / BM; nwg = nM * nN; G = G_; c = c_; }
    __host__ __device__ bool next(int i, Unit& u) const {
        const long L = (long)i * G + c; if (L >= nwg) return false;
        int wgid = (int)L; { const int q = nwg / NXCD, r = nwg % NXCD, xcd = wgid % NXCD, off = wgid / NXCD; wgid = (xcd < r ? xcd * (q + 1) : r * (q + 1) + (xcd - r) * q) + off; }
        const int nig = WGM * nN, gid = wgid / nig, fm = gid * WGM, gsz = (nM - fm) < WGM ? (nM - fm) : WGM;
        u.pm = fm + ((wgid % nig) % gsz); u.pn = (wgid % nig) / gsz; return true;
    }
    __device__ __forceinline__ void a_ready(const Unit&) const {}
    __device__ __forceinline__ void done(const Unit&) const {}
};
typedef float f32x2 __attribute__((ext_vector_type(2)));
typedef __bf16 bf16x2_t __attribute__((ext_vector_type(2)));
__device__ __forceinline__ unsigned cvt_pk_bf16(float lo, float hi) { f32x2 v = {lo, hi}; bf16x2_t b = __builtin_convertvector(v, bf16x2_t); return __builtin_bit_cast(unsigned, b); }
__device__ __forceinline__ float sigmoid_f(float v) { return __builtin_amdgcn_rcpf(1.0f + __expf(-v)); }

struct MergeOrder {
    StaticOrder so;
    __host__ __device__ bool next(int i, Unit& u) const { Unit b; if (!so.next(i >> 1, b)) return false; if (i & 1) { u.pm = b.pm + 128; u.pn = b.pn + 4; } else { u = b; } return true; }
    __device__ __forceinline__ void a_ready(const Unit&) const {}
    __device__ __forceinline__ void done(const Unit&) const {}
};

struct EpiIn {
    static constexpr bool PERM = true, AFTER_DRAIN = false;
    bf16_t* qkv;
    bf16_t* gates;
    const float* bgate;
    __device__ __forceinline__ void operator()(const f32x4 (&acc)[2][2][4][2], const Unit& u, int wr, int wc, int fr, int fq) const {
        const int pn = u.pn; const int row0 = u.pm * BM + wr * 64 + fr;
        if (pn < 12) {
            const int t = pn >> 1; bf16_t* base = qkv + (size_t)t * ((size_t)MTOK * 512);
            const int colt = (pn & 1) * 256 + wc * 32 + 8 * fq;
            if (t == 2 || t == 5) {
#pragma unroll
                for (int ai = 0; ai < 2; ++ai)
#pragma unroll
                    for (int m = 0; m < 4; ++m) { const int row = row0 + ai * HALF + m * 16; const int b = row >> 12, s = row & 4095;
                        bf16_t* p = base + ((size_t)(b * 512 + colt) * 4096 + s);
#pragma unroll
                        for (int bj = 0; bj < 2; ++bj)
#pragma unroll
                            for (int n = 0; n < 2; ++n) { const f32x4 v = acc[ai][bj][m][n]; const unsigned w0 = cvt_pk_bf16(v[0], v[1]), w1 = cvt_pk_bf16(v[2], v[3]);
                                bf16_t* pp = p + (size_t)(bj * HALF + 4 * n) * 4096;
                                pp[0] = (bf16_t)(w0 & 0xffffu); pp[4096] = (bf16_t)(w0 >> 16); pp[2 * 4096] = (bf16_t)(w1 & 0xffffu); pp[3 * 4096] = (bf16_t)(w1 >> 16); } }
            } else {
                const float sc = (t == 0 || t == 3) ? 0.125f : 1.0f;
#pragma unroll
                for (int ai = 0; ai < 2; ++ai)
#pragma unroll
                    for (int m = 0; m < 4; ++m) { bf16_t* rowp = base + (size_t)(row0 + ai * HALF + m * 16) * 512 + colt;
#pragma unroll
                        for (int bj = 0; bj < 2; ++bj) { const f32x4 v0 = acc[ai][bj][m][0] * sc, v1 = acc[ai][bj][m][1] * sc;
                            u32x4 w; w.x = cvt_pk_bf16(v0[0], v0[1]); w.y = cvt_pk_bf16(v0[2], v0[3]); w.z = cvt_pk_bf16(v1[0], v1[1]); w.w = cvt_pk_bf16(v1[2], v1[3]);
                            *(u32x4*)(rowp + bj * HALF) = w; } }
            }
        } else {
            const int gc0 = (pn - 12) * 256 + wc * 32 + 8 * fq;
            f32x4 bv[2][2];
#pragma unroll
            for (int bj = 0; bj < 2; ++bj)
#pragma unroll
                for (int n = 0; n < 2; ++n) bv[bj][n] = *(const f32x4*)(bgate + gc0 + bj * HALF + 4 * n);
#pragma unroll
            for (int ai = 0; ai < 2; ++ai)
#pragma unroll
                for (int m = 0; m < 4; ++m) { bf16_t* rowp = gates + (size_t)(row0 + ai * HALF + m * 16) * 2048 + gc0;
#pragma unroll
                    for (int bj = 0; bj < 2; ++bj) { const f32x4 v0 = acc[ai][bj][m][0] + bv[bj][0], v1 = acc[ai][bj][m][1] + bv[bj][1];
                        u32x4 w; w.x = cvt_pk_bf16(sigmoid_f(v0[0]), sigmoid_f(v0[1])); w.y = cvt_pk_bf16(sigmoid_f(v0[2]), sigmoid_f(v0[3]));
                        w.z = cvt_pk_bf16(sigmoid_f(v1[0]), sigmoid_f(v1[1])); w.w = cvt_pk_bf16(sigmoid_f(v1[2]), sigmoid_f(v1[3]));
                        *(u32x4*)(rowp + bj * HALF) = w; } }
        }
    }
};

struct EpiMerge {
    static constexpr bool PERM = true, AFTER_DRAIN = false;
    const bf16_t* gates; float* T; bf16_t* merged;
    __device__ __forceinline__ void operator()(const f32x4 (&acc)[2][2][4][2], const Unit& u, int wr, int wc, int fr, int fq) const {
        const bool ca = u.pm >= 128; const int pm = u.pm & 127, pn = u.pn & 3;
        const int row0 = pm * BM + wr * 64 + fr, col0 = pn * BM + wc * 32 + 8 * fq;
        const bf16_t* gb = gates + (ca ? 1024 : 0) + col0;
#pragma unroll
        for (int ai = 0; ai < 2; ++ai)
#pragma unroll
            for (int m = 0; m < 4; ++m) { const size_t row = (size_t)(row0 + ai * HALF + m * 16);
#pragma unroll
                for (int bj = 0; bj < 2; ++bj) {
                    const u32x4 gw = *(const u32x4*)(gb + row * 2048 + bj * HALF);
                    f32x4 g0, g1;
                    g0[0] = __uint_as_float(gw.x << 16); g0[1] = __uint_as_float(gw.x & 0xffff0000u); g0[2] = __uint_as_float(gw.y << 16); g0[3] = __uint_as_float(gw.y & 0xffff0000u);
                    g1[0] = __uint_as_float(gw.z << 16); g1[1] = __uint_as_float(gw.z & 0xffff0000u); g1[2] = __uint_as_float(gw.w << 16); g1[3] = __uint_as_float(gw.w & 0xffff0000u);
                    f32x4 v0 = acc[ai][bj][m][0] * g0, v1 = acc[ai][bj][m][1] * g1;
                    float* tp = T + row * 1024 + col0 + bj * HALF;
                    if (!ca) { *(f32x4*)tp = v0; *(f32x4*)(tp + 4) = v1; }
                    else { v0 += *(const f32x4*)tp; v1 += *(const f32x4*)(tp + 4);
                        u32x4 w; w.x = cvt_pk_bf16(v0[0], v0[1]); w.y = cvt_pk_bf16(v0[2], v0[3]); w.z = cvt_pk_bf16(v1[0], v1[1]); w.w = cvt_pk_bf16(v1[2], v1[3]);
                        *(u32x4*)(merged + row * 1024 + col0 + bj * HALF) = w; } } }
    }
};

struct EpiRes {
    static constexpr bool PERM = false, AFTER_DRAIN = false;
    const float* base; float* out; float alpha;
    __device__ __forceinline__ void operator()(const f32x4 (&acc)[2][2][4][2], const Unit& u, int wr, int wc, int fr, int fq) const {
        const int row0 = u.pm * BM + wr * 64 + fr, col0 = u.pn * BM + wc * 32 + 4 * fq;
#pragma unroll
        for (int ai = 0; ai < 2; ++ai)
#pragma unroll
            for (int m = 0; m < 4; ++m) { const size_t off = (size_t)(row0 + ai * HALF + m * 16) * 1024 + col0;
#pragma unroll
                for (int bj = 0; bj < 2; ++bj)
#pragma unroll
                    for (int n = 0; n < 2; ++n) { const f32x4 bs = *(const f32x4*)(base + off + bj * HALF + n * 16); *(f32x4*)(out + off + bj * HALF + n * 16) = bs * alpha + acc[ai][bj][m][n]; } }
    }
};

struct EpiRelu2 {
    static constexpr bool PERM = true, AFTER_DRAIN = false;
    bf16_t* O;
    __device__ __forceinline__ void operator()(const f32x4 (&acc)[2][2][4][2], const Unit& u, int wr, int wc, int fr, int fq) const {
        const int row0 = u.pm * BM + wr * 64 + fr, col0 = u.pn * BM + wc * 32 + 8 * fq;
#pragma unroll
        for (int ai = 0; ai < 2; ++ai)
#pragma unroll
            for (int m = 0; m < 4; ++m) { bf16_t* rowp = O + (size_t)(row0 + ai * HALF + m * 16) * DFF + col0;
#pragma unroll
                for (int bj = 0; bj < 2; ++bj) { f32x4 v0 = acc[ai][bj][m][0], v1 = acc[ai][bj][m][1];
#pragma unroll
                    for (int j = 0; j < 4; ++j) { const float a = fmaxf(v0[j], 0.f), b = fmaxf(v1[j], 0.f); v0[j] = a * a; v1[j] = b * b; }
                    u32x4 w; w.x = cvt_pk_bf16(v0[0], v0[1]); w.y = cvt_pk_bf16(v0[2], v0[3]); w.z = cvt_pk_bf16(v1[0], v1[1]); w.w = cvt_pk_bf16(v1[2], v1[3]);
                    *(u32x4*)(rowp + bj * HALF) = w; } }
    }
};

template <class Epi, class Sched, bool ALIGN_EPI = false, bool SP2 = false>
__device__ __forceinline__ void gemm_phase(PG8_LAS unsigned char* lds, const Gemm g, const Sched& S, const Epi& E) {
    const int tid = threadIdx.x, wid = __builtin_amdgcn_readfirstlane(tid >> 6), lane = tid & 63, wr = wid >> 2, wc = wid & 3, fr = lane & 15, fq = lane >> 4;
    const int K = g.K, nt = K / BK;
    unsigned voffA[2], voffB[2];
#pragma unroll
    for (int i = 0; i < 2; ++i) { int R, C; stage_rc(tid * 16 + i * 8192, R, C); const int Rb = Epi::PERM ? ((R & ~31) + perm32(R & 31)) : R;
        voffA[i] = (unsigned)(R * K + C) * 2u; voffB[i] = (unsigned)(Rb * K + C) * 2u; }
    const size_t kstep = (size_t)(BK * 2);
    const size_t hstep = (size_t)HALF * K * 2;
    const size_t tstep = 2 * hstep;
    const unsigned ldsw = (unsigned)wid * 1024u;
    const int aoff = lds_byte(wr * 64 + fr, fq * 8), boff = lds_byte(wc * 32 + fr, fq * 8);
#define PG8_SA(b, h) (((b) * 2 + (h)) * HTB)
#define PG8_SB(b, h) ((4 + (b) * 2 + (h)) * HTB)
#define PG8_STAGE(bufoff, gbase, voff) do { _Pragma("unroll") for (int _i = 0; _i < 2; ++_i) \
        __builtin_amdgcn_global_load_lds((const unsigned*)((const char*)(gbase) + (voff)[_i]), (PG8_LAS unsigned*)(lds + (bufoff) + ldsw + _i * 8192), 16, 0, 0); } while (0)
#define PG8_LDA(dst, b, h) do { _Pragma("unroll") for (int m = 0; m < 4; ++m) _Pragma("unroll") for (int k = 0; k < 2; ++k) dst[m][k] = *(const PG8_LAS bf16x8*)(lds + PG8_SA(b, h) + aoff + m * 2048 + k * 1024); } while (0)
#define PG8_LDB(dst, b, h) do { _Pragma("unroll") for (int n = 0; n < 2; ++n) _Pragma("unroll") for (int k = 0; k < 2; ++k) dst[n][k] = *(const PG8_LAS bf16x8*)(lds + PG8_SB(b, h) + boff + n * 2048 + k * 1024); } while (0)
#define PG8_MMA(ai, bj, At, Bt) do { __builtin_amdgcn_s_setprio(1); _Pragma("unroll") for (int m = 0; m < 4; ++m) _Pragma("unroll") for (int n = 0; n < 2; ++n) _Pragma("unroll") for (int k = 0; k < 2; ++k) \
        acc[ai][bj][m][n] = __builtin_amdgcn_mfma_f32_16x16x32_bf16(Bt[n][k], At[m][k], acc[ai][bj][m][n], 0, 0, 0); __builtin_amdgcn_s_setprio(0); } while (0)
#define PG8_WAIT_V(n) asm volatile("s_waitcnt vmcnt(" #n ")" ::: "memory")
#define PG8_WAIT_L(n) asm volatile("s_waitcnt lgkmcnt(" #n ")" ::: "memory")
#define PG8_BAR __builtin_amdgcn_s_barrier()
#define PG8_SCHED __builtin_amdgcn_sched_barrier(0)
    Unit cur, nxt; int ui = 0;
    if (!S.next(0, cur)) return;
    f32x4 acc[2][2][4][2];
#pragma unroll
    for (int a = 0; a < 2; ++a)
#pragma unroll
        for (int b = 0; b < 2; ++b)
#pragma unroll
            for (int m = 0; m < 4; ++m)
#pragma unroll
                for (int n = 0; n < 2; ++n) acc[a][b][m][n] = (f32x4){0.f, 0.f, 0.f, 0.f};
    bf16x8 At[4][2], B0[2][2], B1[2][2];
    const char* cA = (const char*)g.A + (size_t)cur.pm * tstep; const char* cB = (const char*)g.Bt + (size_t)cur.pn * tstep;
    S.a_ready(cur);
    if constexpr (SP2) {
        PG8_STAGE(PG8_SB(0, 0), cB, voffB); PG8_STAGE(PG8_SB(0, 1), cB + hstep, voffB); PG8_STAGE(PG8_SA(0, 0), cA, voffA); PG8_STAGE(PG8_SA(0, 1), cA + hstep, voffA);
        if (wr == 1) PG8_BAR;
        PG8_WAIT_V(2); PG8_BAR;
        PG8_STAGE(PG8_SB(1, 0), cB + kstep, voffB); PG8_STAGE(PG8_SA(1, 0), cA + kstep, voffA); PG8_STAGE(PG8_SB(1, 1), cB + hstep + kstep, voffB);
        PG8_WAIT_V(6); PG8_BAR;
    } else {
        PG8_STAGE(PG8_SB(0, 0), cB, voffB); PG8_STAGE(PG8_SA(0, 0), cA, voffA); PG8_STAGE(PG8_SB(0, 1), cB + hstep, voffB); PG8_STAGE(PG8_SA(0, 1), cA + hstep, voffA);
        if (wr == 1) PG8_BAR;
        PG8_WAIT_V(4); PG8_BAR;
        PG8_STAGE(PG8_SB(1, 0), cB + kstep, voffB); PG8_STAGE(PG8_SA(1, 0), cA + kstep, voffA); PG8_STAGE(PG8_SB(1, 1), cB + hstep + kstep, voffB);
        PG8_WAIT_V(6); PG8_BAR;
    }
    for (;;) {
        const bool has_next = S.next(ui + 1, nxt);
        const char* nA = has_next ? (const char*)g.A + (size_t)nxt.pm * tstep : cA; const char* nB = has_next ? (const char*)g.Bt + (size_t)nxt.pn * tstep : cB;
        for (int t = 0; t < nt; t += 2) {
            const bool last = (t == nt - 2);
            const char* a1 = cA + (size_t)(t + 1) * kstep;
            const char* a2 = last ? nA : cA + (size_t)(t + 2) * kstep; const char* b2 = last ? nB : cB + (size_t)(t + 2) * kstep;
            const char* a3 = a2 + kstep; const char* b3 = b2 + kstep;
            if (last && has_next) S.a_ready(nxt);
            if constexpr (SP2) {
            PG8_LDB(B0, 0, 0); PG8_LDB(B1, 0, 1); PG8_SCHED; PG8_LDA(At, 0, 0); PG8_STAGE(PG8_SA(1, 1), a1 + hstep, voffA);
            PG8_WAIT_V(8); PG8_WAIT_L(0); PG8_BAR; PG8_MMA(0, 0, At, B0); PG8_MMA(0, 1, At, B1); PG8_BAR; PG8_SCHED;
            PG8_LDA(At, 0, 1); PG8_STAGE(PG8_SB(0, 0), b2, voffB); PG8_STAGE(PG8_SB(0, 1), b2 + hstep, voffB); PG8_STAGE(PG8_SA(0, 0), a2, voffA);
            PG8_WAIT_V(8); PG8_WAIT_L(0); PG8_BAR; PG8_MMA(1, 0, At, B0); PG8_MMA(1, 1, At, B1); PG8_BAR; PG8_SCHED;
            PG8_LDB(B0, 1, 0); PG8_LDB(B1, 1, 1); PG8_SCHED; PG8_LDA(At, 1, 0); PG8_STAGE(PG8_SA(0, 1), a2 + hstep, voffA);
            PG8_WAIT_V(8); PG8_WAIT_L(0); PG8_BAR; PG8_MMA(0, 0, At, B0); PG8_MMA(0, 1, At, B1); PG8_BAR; PG8_SCHED;
            PG8_LDA(At, 1, 1); PG8_STAGE(PG8_SB(1, 0), b3, voffB); PG8_STAGE(PG8_SB(1, 1), b3 + hstep, voffB); PG8_STAGE(PG8_SA(1, 0), a3, voffA);
            PG8_WAIT_V(8); PG8_WAIT_L(0); PG8_BAR; PG8_MMA(1, 0, At, B0); PG8_MMA(1, 1, At, B1); PG8_BAR; PG8_SCHED;
            } else {
            PG8_LDB(B0, 0, 0); PG8_SCHED; PG8_LDA(At, 0, 0); PG8_STAGE(PG8_SA(1, 1), a1 + hstep, voffA);
            PG8_WAIT_L(8); PG8_BAR; PG8_WAIT_L(0); PG8_MMA(0, 0, At, B0); PG8_BAR; PG8_SCHED;
            PG8_LDB(B1, 0, 1); PG8_STAGE(PG8_SB(0, 0), b2, voffB);
            PG8_BAR; PG8_WAIT_L(0); PG8_MMA(0, 1, At, B1); PG8_BAR;
            PG8_LDA(At, 0, 1); PG8_STAGE(PG8_SA(0, 0), a2, voffA);
            PG8_BAR; PG8_WAIT_L(0); PG8_MMA(1, 0, At, B0); PG8_BAR; PG8_SCHED;
            PG8_STAGE(PG8_SB(0, 1), b2 + hstep, voffB);
            PG8_WAIT_V(6); PG8_BAR; PG8_MMA(1, 1, At, B1); PG8_BAR;
            PG8_LDB(B0, 1, 0); PG8_SCHED; PG8_LDA(At, 1, 0); PG8_STAGE(PG8_SA(0, 1), a2 + hstep, voffA);
            PG8_WAIT_L(8); PG8_BAR; PG8_WAIT_L(0); PG8_MMA(0, 0, At, B0); PG8_BAR; PG8_SCHED;
            PG8_LDB(B1, 1, 1); PG8_STAGE(PG8_SB(1, 0), b3, voffB);
            PG8_BAR; PG8_WAIT_L(0); PG8_MMA(0, 1, At, B1); PG8_BAR;
            PG8_LDA(At, 1, 1); PG8_STAGE(PG8_SA(1, 0), a3, voffA);
            PG8_BAR; PG8_WAIT_L(0); PG8_MMA(1, 0, At, B0); PG8_BAR; PG8_SCHED;
            PG8_STAGE(PG8_SB(1, 1), b3 + hstep, voffB);
            PG8_WAIT_V(6); PG8_BAR; PG8_MMA(1, 1, At, B1); PG8_BAR;
            }
        }
        if constexpr (ALIGN_EPI) { if (wr == 0) PG8_BAR; }
        if constexpr (!Epi::AFTER_DRAIN) { E(acc, cur, wr, wc, fr, fq); S.done(cur); }
        if (!has_next) break;
#pragma unroll
        for (int a = 0; a < 2; ++a)
#pragma unroll
            for (int b = 0; b < 2; ++b)
#pragma unroll
                for (int m = 0; m < 4; ++m)
#pragma unroll
                    for (int n = 0; n < 2; ++n) acc[a][b][m][n] = (f32x4){0.f, 0.f, 0.f, 0.f};
        cur = nxt; cA = nA; cB = nB; ++ui;
        if constexpr (ALIGN_EPI) { if (wr == 1) PG8_BAR; }
    }
    PG8_WAIT_V(0);
    if constexpr (!ALIGN_EPI) { if (wr == 0) PG8_BAR; }
    PG8_BAR;
    if constexpr (Epi::AFTER_DRAIN) { E.fused(acc, cur, wr, wc, fr, fq, lds, wid, lane); S.done(cur); }
#undef PG8_SA
#undef PG8_SB
#undef PG8_STAGE
#undef PG8_LDA
#undef PG8_LDB
#undef PG8_MMA
#undef PG8_WAIT_V
#undef PG8_WAIT_L
#undef PG8_BAR
#undef PG8_SCHED
}
}

#define GAS __attribute__((address_space(1)))
#define LAS __attribute__((address_space(3)))
typedef unsigned short bf16;
typedef unsigned v4u __attribute__((ext_vector_type(4)));
typedef unsigned v2u __attribute__((ext_vector_type(2)));
typedef float f32x4 __attribute__((ext_vector_type(4)));
typedef float f32x16 __attribute__((ext_vector_type(16)));
typedef short bf16x8 __attribute__((ext_vector_type(8)));
typedef short s16x4 __attribute__((ext_vector_type(4)));
constexpr int NWAVES = 8;
constexpr float LN_EPS = 1e-5f;
constexpr float DN_ALPHA = 1.189207115002721f;
constexpr int LDS_BYTES = 147456;
#define LDS_WAIT() asm volatile("s_waitcnt lgkmcnt(0)" ::: "memory")

constexpr size_t MiB = 1u << 20;
constexpr size_t WS_W_IN = 2 * MiB, WS_W_SC = 12 * MiB, WS_W_OUT = 14 * MiB, WS_W_MI = 16 * MiB, WS_W_MO = 24 * MiB;
constexpr size_t WS_XB = 32 * MiB;
constexpr size_t WS_QKV = 96 * MiB;
constexpr size_t WS_GATES = 288 * MiB;
constexpr size_t WS_O2 = 416 * MiB;
constexpr size_t WS_T = 96 * MiB;
constexpr size_t WS_MERGED = 224 * MiB;
constexpr size_t WS_H = 96 * MiB;
constexpr size_t WS_END = 480 * MiB;

__device__ __forceinline__ float wave_sum(float v) {
#pragma unroll
    for (int o = 1; o < 64; o <<= 1) v += __shfl_xor(v, o);
    return v;
}
__device__ __forceinline__ unsigned pk2(float lo, float hi) { return pg8::cvt_pk_bf16(lo, hi); }

__device__ __forceinline__ void p0_transpose_item(const float* W, int K, int N, bf16* WT, int row_off, LAS float* scr, int item, int lane) {
    const int nblk = N / 32, kb = item / nblk, nb = item % nblk, k0 = 64 * kb, n0 = 32 * nb;
#pragma unroll 8
    for (int i = 0; i < 32; ++i) { const int kk = 2 * i + (lane >> 5); scr[kk * 33 + (lane & 31)] = W[(size_t)(k0 + kk) * N + n0 + (lane & 31)]; }
    LDS_WAIT(); asm volatile("" ::: "memory");
    const int c = lane & 7;
#pragma unroll
    for (int j = 0; j < 4; ++j) { const int n = (lane >> 3) + 8 * j; const LAS float* s = scr + (8 * c) * 33 + n;
        v4u o; o.x = pk2(s[0 * 33], s[1 * 33]); o.y = pk2(s[2 * 33], s[3 * 33]); o.z = pk2(s[4 * 33], s[5 * 33]); o.w = pk2(s[6 * 33], s[7 * 33]);
        *(GAS v4u*)(WT + (size_t)(row_off + n0 + n) * K + k0 + 8 * c) = o; }
    LDS_WAIT(); asm volatile("" ::: "memory");
}

__device__ __forceinline__ void row_to_bf16(const float* xrow, bf16* orow, int lane) {
    const f32x4* xr = (const f32x4*)xrow + lane; v2u* o8 = (v2u*)orow + lane;
#pragma unroll
    for (int j = 0; j < 4; ++j) { const f32x4 v = xr[64 * j]; v2u w; w.x = pk2(v[0], v[1]); w.y = pk2(v[2], v[3]); o8[64 * j] = w; }
}
__device__ __forceinline__ void ln_row(float* row, bf16* brow, const float* g, const float* bta, int lane) {
    f32x4* xr = (f32x4*)row + lane; f32x4 v[4]; float s = 0.f;
#pragma unroll
    for (int j = 0; j < 4; ++j) { v[j] = xr[64 * j]; s += (v[j][0] + v[j][1]) + (v[j][2] + v[j][3]); }
    const float mean = wave_sum(s) * (1.f / 1024.f); float s2 = 0.f;
#pragma unroll
    for (int j = 0; j < 4; ++j) { v[j] = v[j] - mean; s2 += (v[j][0] * v[j][0] + v[j][1] * v[j][1]) + (v[j][2] * v[j][2] + v[j][3] * v[j][3]); }
    const float rstd = 1.f / sqrtf(wave_sum(s2) * (1.f / 1024.f) + LN_EPS);
#pragma unroll
    for (int j = 0; j < 4; ++j) { const f32x4 gg = ((const f32x4*)g)[lane + 64 * j], bb = ((const f32x4*)bta)[lane + 64 * j]; const f32x4 y = v[j] * rstd * gg + bb; xr[64 * j] = y;
        if (brow) { v2u w; w.x = pk2(y[0], y[1]); w.y = pk2(y[2], y[3]); ((v2u*)brow)[lane + 64 * j] = w; } }
}

#define MFMA32(a, b, c) __builtin_amdgcn_mfma_f32_32x32x16_bf16((a), (b), (c), 0, 0, 0)
__device__ __forceinline__ int crow(int reg, int h) { return (reg & 3) + 8 * (reg >> 2) + 4 * h; }
__device__ __forceinline__ void load_frag4(bf16x8 (&f)[4], const bf16* p, int r, int hi) {
    const bf16x8* q = (const bf16x8*)(p + (size_t)r * 512 + 8 * hi);
#pragma unroll
    for (int s = 0; s < 4; ++s) f[s] = q[2 * s];
}
__device__ __forceinline__ void load_vt(bf16x8 (&v)[2][2], const bf16* p, int r, int hi) {
#pragma unroll
    for (int db = 0; db < 2; ++db)
#pragma unroll
        for (int s = 0; s < 2; ++s) { const s16x4* q = (const s16x4*)(p + (size_t)(db * 32 + r) * 4096 + 16 * s + 4 * hi); const s16x4 lo = q[0], hh = q[2];
            v[db][s] = __builtin_shufflevector(lo, hh, 0, 1, 2, 3, 4, 5, 6, 7); }
}
__device__ __forceinline__ bf16x8 pack8(const float (&p)[16], int s) {
    v4u w; w.x = pk2(p[8 * s], p[8 * s + 1]); w.y = pk2(p[8 * s + 2], p[8 * s + 3]); w.z = pk2(p[8 * s + 4], p[8 * s + 5]); w.w = pk2(p[8 * s + 6], p[8 * s + 7]);
    return __builtin_bit_cast(bf16x8, w);
}
__device__ __forceinline__ void store_o(bf16* orow  , const f32x16& o0, const f32x16& o1, float sc, int hi) {
#pragma unroll
    for (int g = 0; g < 4; ++g) { v2u w0, w1;
        w0.x = pk2(o0[4 * g] * sc, o0[4 * g + 1] * sc); w0.y = pk2(o0[4 * g + 2] * sc, o0[4 * g + 3] * sc);
        w1.x = pk2(o1[4 * g] * sc, o1[4 * g + 1] * sc); w1.y = pk2(o1[4 * g + 2] * sc, o1[4 * g + 3] * sc);
        *(v2u*)(orow + 8 * g + 4 * hi) = w0; *(v2u*)(orow + 32 + 8 * g + 4 * hi) = w1; }
}

__device__ __forceinline__ void sb_unit(const bf16* Q, const bf16* K, const bf16* VT, bf16* O, int bh, int qb, int lane) {
    const int r = lane & 31, hi = lane >> 5, b = bh >> 3, h = bh & 7;
    const size_t rowbase = (size_t)b * SEQL;
    const bf16* Kh = K + rowbase * 512 + h * 64;
    const bf16* VTh = VT + (size_t)bh * 64 * 4096;
    bf16x8 qf[4], kf[4];
    load_frag4(qf, Q + (rowbase + qb * 32) * 512 + h * 64, r, hi);
    load_frag4(kf, Kh + (size_t)(qb * 32) * 512, r, hi);
    f32x16 o0, o1;
#pragma unroll
    for (int i = 0; i < 16; ++i) { o0[i] = 0.f; o1[i] = 0.f; }
    float R = 0.f;
    for (int kb = qb; kb >= 0; --kb) {
        bf16x8 vf[2][2], kn[4];
        load_vt(vf, VTh + kb * 32, r, hi);
        load_frag4(kn, Kh + (size_t)((kb > 0 ? kb - 1 : 0) * 32) * 512, r, hi);
        f32x16 z;
#pragma unroll
        for (int i = 0; i < 16; ++i) z[i] = 0.f;
#pragma unroll
        for (int s = 0; s < 4; ++s) z = MFMA32(kf[s], qf[s], z);
        const bool diag = (kb == qb);
        float lk[16], ls[16], G[4];
#pragma unroll
        for (int g = 0; g < 4; ++g) G[g] = 0.f;
#pragma unroll
        for (int i = 0; i < 16; ++i) {
            const float zi = z[i];
            const bool valid = !diag || (crow(i, hi) < r);
            const float sp = fmaxf(zi, 0.f) + __logf(1.0f + __expf(-fabsf(zi)));
            lk[i] = valid ? -sp : 0.f;
            ls[i] = valid ? (zi - sp) : -INFINITY;
            G[i >> 2] += lk[i];
        }
        float Hh[4], A[4];
#pragma unroll
        for (int g = 0; g < 4; ++g) Hh[g] = __shfl_xor(G[g], 32);
        float run = 0.f;
#pragma unroll
        for (int g = 3; g >= 0; --g) { A[g] = run + (hi ? 0.f : Hh[g]); run += G[g] + Hh[g]; }
        float p[16];
#pragma unroll
        for (int g = 0; g < 4; ++g) { float e = R + A[g];
#pragma unroll
            for (int j = 3; j >= 0; --j) { p[4 * g + j] = __expf(ls[4 * g + j] + e); e += lk[4 * g + j]; } }
        R += run;
        const bf16x8 p0 = pack8(p, 0), p1 = pack8(p, 1);
        o0 = MFMA32(vf[0][0], p0, o0); o0 = MFMA32(vf[0][1], p1, o0);
        o1 = MFMA32(vf[1][0], p0, o1); o1 = MFMA32(vf[1][1], p1, o1);
#pragma unroll
        for (int s = 0; s < 4; ++s) kf[s] = kn[s];
        if (__all(R < -106.0f)) break;
    }
    store_o(O + (rowbase + qb * 32 + r) * 512 + h * 64, o0, o1, 1.0f, hi);
}

__device__ __forceinline__ void ca_unit(const bf16* Q, const bf16* K, const bf16* VT, bf16* O, const LAS float* tab, int bh, int c, int hf, int lane) {
    const int r = lane & 31, hi = lane >> 5, b = bh >> 3, h = bh & 7;
    const size_t rowbase = (size_t)b * SEQL;
    const bf16* Kh = K + rowbase * 512 + h * 64;
    const bf16* VTh = VT + (size_t)bh * 64 * 4096;
    const int t0 = c * 64 + hf * 32;
    const int kb0 = (c > 8 ? c - 8 : 0) * 2, kb1 = (c + 1) * 2;
    bf16x8 qf[4], kf[4];
    load_frag4(qf, Q + (rowbase + t0) * 512 + h * 64, r, hi);
    load_frag4(kf, Kh + (size_t)(kb0 * 32) * 512, r, hi);
    f32x16 o0, o1;
#pragma unroll
    for (int i = 0; i < 16; ++i) { o0[i] = 0.f; o1[i] = 0.f; }
    float mrun = -INFINITY, l = 0.f;
    const float bias_far = tab[512];
    for (int kb = kb0; kb < kb1; ++kb) {
        bf16x8 vf[2][2], kn[4];
        load_vt(vf, VTh + kb * 32, r, hi);
        load_frag4(kn, Kh + (size_t)((kb + 1 < kb1 ? kb + 1 : kb) * 32) * 512, r, hi);
        f32x16 z;
#pragma unroll
        for (int i = 0; i < 16; ++i) z[i] = 0.f;
#pragma unroll
        for (int s = 0; s < 4; ++s) z = MFMA32(kf[s], qf[s], z);
        const int k0 = kb * 32;
        float zz[16];
        if (t0 - (k0 + 31) >= 256) {
#pragma unroll
            for (int i = 0; i < 16; ++i) zz[i] = z[i] + bias_far;
        } else {
            const int d0 = t0 + r - k0 + 256;
#pragma unroll
            for (int i = 0; i < 16; ++i) { int idx = d0 - crow(i, hi); idx = idx < 0 ? 0 : (idx > 512 ? 512 : idx); zz[i] = z[i] + tab[idx]; }
        }
        float mx = zz[0];
#pragma unroll
        for (int i = 1; i < 16; ++i) mx = fmaxf(mx, zz[i]);
        mx = fmaxf(mx, __shfl_xor(mx, 32));
        const float mnew = fmaxf(mrun, mx);
        const float alpha = __expf(mrun - mnew);
        float p[16]; float ps = 0.f;
#pragma unroll
        for (int i = 0; i < 16; ++i) { p[i] = __expf(zz[i] - mnew); ps += p[i]; }
        l = l * alpha + ps; mrun = mnew;
#pragma unroll
        for (int i = 0; i < 16; ++i) { o0[i] *= alpha; o1[i] *= alpha; }
        const bf16x8 p0 = pack8(p, 0), p1 = pack8(p, 1);
        o0 = MFMA32(vf[0][0], p0, o0); o0 = MFMA32(vf[0][1], p1, o0);
        o1 = MFMA32(vf[1][0], p0, o1); o1 = MFMA32(vf[1][1], p1, o1);
#pragma unroll
        for (int s = 0; s < 4; ++s) kf[s] = kn[s];
    }
    l += __shfl_xor(l, 32);
    store_o(O + (rowbase + t0 + r) * 512 + h * 64, o0, o1, 1.0f / l, hi);
}

struct Args { const float* x; const float* w_in; const float* b_gate; const float* w_sb; const float* w_ca; const float* rel_bias; const float* w_out; const float* ln1_g; const float* ln1_b;
              const float* w_mi; const float* w_mo; const float* ln2_g; const float* ln2_b; float* out; unsigned char* ws; };

__global__ void __launch_bounds__(NWAVES * 64, 2) mk_fwd(Args a) {
    extern __shared__ __attribute__((aligned(16))) unsigned char lds_raw[];
    LAS unsigned char* lds = (LAS unsigned char*)lds_raw;
    cg::grid_group grid = cg::this_grid();
    const int tid = threadIdx.x, lane = tid & 63, wave = __builtin_amdgcn_readfirstlane(tid >> 6);
    const int G = gridDim.x, bx = blockIdx.x;
    const int vcu = (G % 8 == 0) ? (bx % 8) * (G / 8) + bx / 8 : bx;
    const int gw = vcu * NWAVES + wave, NGW = G * NWAVES;
    unsigned char* ws = a.ws;
    bf16* W_IN = (bf16*)(ws + WS_W_IN); bf16* W_SC = (bf16*)(ws + WS_W_SC); bf16* W_OUT = (bf16*)(ws + WS_W_OUT); bf16* W_MI = (bf16*)(ws + WS_W_MI); bf16* W_MO = (bf16*)(ws + WS_W_MO);
    bf16* XB = (bf16*)(ws + WS_XB); bf16* QKV = (bf16*)(ws + WS_QKV); bf16* GATES = (bf16*)(ws + WS_GATES); bf16* O2 = (bf16*)(ws + WS_O2);
    float* T = (float*)(ws + WS_T); bf16* MERGED = (bf16*)(ws + WS_MERGED); bf16* HB = (bf16*)(ws + WS_H);
    constexpr size_t QSZ = (size_t)MTOK * 512;

    {
        LAS float* scr = (LAS float*)(lds + wave * 16384);
        constexpr int I_IN = (DMODEL / 64) * (NINC / 32), I_SB = (WIDTH / 64) * (DMODEL / 32), I_OUT = (DMODEL / 64) * (DMODEL / 32), I_MI = (DMODEL / 64) * (DFF / 32), I_MO = (DFF / 64) * (DMODEL / 32);
        constexpr int NITEMS = I_IN + 2 * I_SB + I_OUT + I_MI + I_MO;
        for (int it = gw; it < NITEMS; it += NGW) {
            int q = it;
            if (q < I_IN) { p0_transpose_item(a.w_in, DMODEL, NINC, W_IN, 0, scr, q, lane); continue; } q -= I_IN;
            if (q < I_SB) { p0_transpose_item(a.w_sb, WIDTH, DMODEL, W_SC, 0, scr, q, lane); continue; } q -= I_SB;
            if (q < I_SB) { p0_transpose_item(a.w_ca, WIDTH, DMODEL, W_SC, DMODEL, scr, q, lane); continue; } q -= I_SB;
            if (q < I_OUT) { p0_transpose_item(a.w_out, DMODEL, DMODEL, W_OUT, 0, scr, q, lane); continue; } q -= I_OUT;
            if (q < I_MI) { p0_transpose_item(a.w_mi, DMODEL, DFF, W_MI, 0, scr, q, lane); continue; } q -= I_MI;
            p0_transpose_item(a.w_mo, DFF, DMODEL, W_MO, 0, scr, q, lane);
        }
        for (int m = gw; m < MTOK; m += NGW) row_to_bf16(a.x + (size_t)m * DMODEL, XB + (size_t)m * DMODEL, lane);
    }
    grid.sync();

    {
        pg8::Gemm g{XB, W_IN, MTOK, NINC, DMODEL}; pg8::StaticOrder S; S.init(MTOK, NINC, G, bx);
        pg8::EpiIn E{QKV, GATES, a.b_gate};
        pg8::gemm_phase<pg8::EpiIn, pg8::StaticOrder, true, true>(lds, g, S, E);
    }
    grid.sync();

    {
        LAS float* tab = (LAS float*)lds;
        for (int i = tid; i < NHEADS * 513; i += NWAVES * 64) tab[i] = a.rel_bias[i];
        __syncthreads();
        for (int u = gw; u < 16384; u += NGW) {
            if (u < 8192) { const int bh = u >> 7, qb = u & 127; sb_unit(QKV, QKV + QSZ, QKV + 2 * QSZ, O2, bh, qb, lane); }
            else { const int v = u - 8192, bh = v >> 7, c = (v & 127) >> 1, hf = v & 1; ca_unit(QKV + 3 * QSZ, QKV + 4 * QSZ, QKV + 5 * QSZ, O2 + QSZ, tab + (bh & 7) * 513, bh, c, hf, lane); }
        }
        __syncthreads();
    }
    grid.sync();

    {
        pg8::Gemm g{O2, W_SC, 2 * MTOK, 2 * DMODEL, WIDTH}; pg8::MergeOrder S; S.so.init(MTOK, DMODEL, G, bx);
        pg8::EpiMerge E{GATES, T, MERGED};
        pg8::gemm_phase<pg8::EpiMerge, pg8::MergeOrder, true, true>(lds, g, S, E);
    }
    grid.sync();

    {
        pg8::Gemm g{MERGED, W_OUT, MTOK, DMODEL, DMODEL}; pg8::StaticOrder S; S.init(MTOK, DMODEL, G, bx);
        pg8::EpiRes E{a.x, a.out, DN_ALPHA};
        pg8::gemm_phase<pg8::EpiRes, pg8::StaticOrder, true, true>(lds, g, S, E);
    }
    grid.sync();

    for (int m = gw; m < MTOK; m += NGW) ln_row(a.out + (size_t)m * DMODEL, XB + (size_t)m * DMODEL, a.ln1_g, a.ln1_b, lane);
    grid.sync();

    {
        pg8::Gemm g{XB, W_MI, MTOK, DFF, DMODEL}; pg8::StaticOrder S; S.init(MTOK, DFF, G, bx);
        pg8::EpiRelu2 E{HB};
        pg8::gemm_phase<pg8::EpiRelu2, pg8::StaticOrder, true, true>(lds, g, S, E);
    }
    grid.sync();

    {
        pg8::Gemm g{HB, W_MO, MTOK, DMODEL, DFF}; pg8::StaticOrder S; S.init(MTOK, DMODEL, G, bx);
        pg8::EpiRes E{a.out, a.out, DN_ALPHA};
        pg8::gemm_phase<pg8::EpiRes, pg8::StaticOrder, true, true>(lds, g, S, E);
    }
    grid.sync();

    for (int m = gw; m < MTOK; m += NGW) ln_row(a.out + (size_t)m * DMODEL, nullptr, a.ln2_g, a.ln2_b, lane);
}

extern "C" void kernel_launch(void* const* d_in, const int* in_sizes, int n_in, void* d_out, int out_size, void* d_ws, size_t ws_size, hipStream_t stream) {
    static int grid = 0;
    if (grid == 0) {
        if (n_in != 13 || in_sizes[0] != MTOK * DMODEL || out_size != MTOK * DMODEL || ws_size < WS_END) { fprintf(stderr, "kernel_launch: unexpected shapes (n_in %d, in0 %d, out %d, ws %zu); nothing launched\n", n_in, n_in > 0 ? in_sizes[0] : -1, out_size, ws_size); grid = -1; return; }
        int dev = 0, cus = 0, per_cu = 0;
        if (hipGetDevice(&dev) != hipSuccess || hipDeviceGetAttribute(&cus, hipDeviceAttributeMultiprocessorCount, dev) != hipSuccess) { fprintf(stderr, "kernel_launch: device query failed\n"); grid = -1; return; }
        if (hipFuncSetAttribute((const void*)mk_fwd, hipFuncAttributeMaxDynamicSharedMemorySize, LDS_BYTES) != hipSuccess) { fprintf(stderr, "kernel_launch: hipFuncSetAttribute failed\n"); grid = -1; return; }
        if (hipOccupancyMaxActiveBlocksPerMultiprocessor(&per_cu, (const void*)mk_fwd, NWAVES * 64, LDS_BYTES) != hipSuccess || per_cu < 1) { fprintf(stderr, "kernel_launch: occupancy query says %d blocks per CU\n", per_cu); per_cu = 1; }
        (void)hipGetLastError();
        grid = cus * 1;
    }
    if (grid < 0) return;
    Args a{};
    a.x = (const float*)d_in[0]; a.w_in = (const float*)d_in[1]; a.b_gate = (const float*)d_in[2]; a.w_sb = (const float*)d_in[3]; a.w_ca = (const float*)d_in[4]; a.rel_bias = (const float*)d_in[5];
    a.w_out = (const float*)d_in[6]; a.ln1_g = (const float*)d_in[7]; a.ln1_b = (const float*)d_in[8]; a.w_mi = (const float*)d_in[9]; a.w_mo = (const float*)d_in[10]; a.ln2_g = (const float*)d_in[11]; a.ln2_b = (const float*)d_in[12];
    a.out = (float*)d_out; a.ws = (unsigned char*)d_ws;
    void* args[] = {&a};
    const hipError_t e = hipLaunchCooperativeKernel((const void*)mk_fwd, dim3(grid), dim3(NWAVES * 64), args, LDS_BYTES, stream);
    if (e != hipSuccess) fprintf(stderr, "kernel_launch: cooperative launch failed: %s (grid %d)\n", hipGetErrorString(e), grid);
}
```

```cpp
#include <hip/hip_runtime.h>
#include <hip/hip_cooperative_groups.h>
#include <cstdio>
#include <cstdint>
namespace cg = cooperative_groups;
constexpr int MTOK = 32768, DMODEL = 1024, SEQL = 4096, NBATCH = 8, NHEADS = 8, WIDTH = 512, DFF = 4096, NINC = 5120;
namespace pg8 {
#define PG8_LAS __attribute__((address_space(3)))
typedef unsigned short bf16_t;
typedef short bf16x8 __attribute__((ext_vector_type(8)));
typedef float f32x4 __attribute__((ext_vector_type(4)));
typedef unsigned u32x4 __attribute__((ext_vector_type(4)));
constexpr int BM = 256, BK = 64, HALF = 128, HTB = HALF * BK * 2  , STAGE_BYTES = 8 * HTB, NXCD = 8, WGM = 8;

__host__ __device__ __forceinline__ int lds_byte(int r, int c) { const int st = (r >> 4) * 2 + (c >> 5), rr = r & 15, cc = c & 31, ob = rr * 64 + cc * 2; return st * 1024 + (ob ^ (((ob >> 9) & 1) << 5)); }
__host__ __device__ __forceinline__ void stage_rc(int b, int& R, int& C) { const int st = b / 1024, sb = b % 1024, swz = sb ^ (((sb >> 9) & 1) << 5); R = (st >> 1) * 16 + swz / 64; C = (st & 1) * 32 + (swz % 64) / 2; }
__host__ __device__ __forceinline__ int perm32(int rho) { const int n = rho >> 4, i = rho & 15; return 8 * (i >> 2) + 4 * n + (i & 3); }

struct Unit { int pm, pn; };
struct Gemm { const bf16_t* A; const bf16_t* Bt; int M, N, K; };

struct StaticOrder {
    int nM, nN, nwg, G, c;
    __host__ __device__ void init(int M, int N, int G_, int c_) { nM = M / BM; nN = N / BM; nwg = nM * nN; G = G_; c = c_; }
    __host__ __device__ bool next(int i, Unit& u) const {
        const long L = (long)i * G + c; if (L >= nwg) return false;
        int wgid = (int)L; { const int q = nwg / NXCD, r = nwg % NXCD, xcd = wgid % NXCD, off = wgid / NXCD; wgid = (xcd < r ? xcd * (q + 1) : r * (q + 1) + (xcd - r) * q) + off; }
        const int nig = WGM * nN, gid = wgid / nig, fm = gid * WGM, gsz = (nM - fm) < WGM ? (nM - fm) : WGM;
        u.pm = fm + ((wgid % nig) % gsz); u.pn = (wgid % nig) / gsz; return true;
    }
    __device__ __forceinline__ void a_ready(const Unit&) const {}
    __device__ __forceinline__ void done(const Unit&) const {}
};
typedef float f32x2 __attribute__((ext_vector_type(2)));
typedef __bf16 bf16x2_t __attribute__((ext_vector_type(2)));
__device__ __forceinline__ unsigned cvt_pk_bf16(float lo, float hi) { f32x2 v = {lo, hi}; bf16x2_t b = __builtin_convertvector(v, bf16x2_t); return __builtin_bit_cast(unsigned, b); }
__device__ __forceinline__ float sigmoid_f(float v) { return __builtin_amdgcn_rcpf(1.0f + __expf(-v)); }

struct MergeOrder {
    StaticOrder so;
    __host__ __device__ bool next(int i, Unit& u) const { Unit b; if (!so.next(i >> 1, b)) return false; if (i & 1) { u.pm = b.pm + 128; u.pn = b.pn + 4; } else { u = b; } return true; }
    __device__ __forceinline__ void a_ready(const Unit&) const {}
    __device__ __forceinline__ void done(const Unit&) const {}
};

struct EpiIn {
    static constexpr bool PERM = true, AFTER_DRAIN = false;
    bf16_t* qkv;
    bf16_t* gates;
    const float* bgate;
    __device__ __forceinline__ void operator()(const f32x4 (&acc)[2][2][4][2], const Unit& u, int wr, int wc, int fr, int fq) const {
        const int pn = u.pn; const int row0 = u.pm * BM + wr * 64 + fr;
        if (pn < 12) {
            const int t = pn >> 1; bf16_t* base = qkv + (size_t)t * ((size_t)MTOK * 512);
            const int colt = (pn & 1) * 256 + wc * 32 + 8 * fq;
            if (t == 2 || t == 5) {
#pragma unroll
                for (int ai = 0; ai < 2; ++ai)
#pragma unroll
                    for (int m = 0; m < 4; ++m) { const int row = row0 + ai * HALF + m * 16; const int b = row >> 12, s = row & 4095;
                        bf16_t* p = base + ((size_t)(b * 512 + colt) * 4096 + s);
#pragma unroll
                        for (int bj = 0; bj < 2; ++bj)
#pragma unroll
                            for (int n = 0; n < 2; ++n) { const f32x4 v = acc[ai][bj][m][n]; const unsigned w0 = cvt_pk_bf16(v[0], v[1]), w1 = cvt_pk_bf16(v[2], v[3]);
                                bf16_t* pp = p + (size_t)(bj * HALF + 4 * n) * 4096;
                                pp[0] = (bf16_t)(w0 & 0xffffu); pp[4096] = (bf16_t)(w0 >> 16); pp[2 * 4096] = (bf16_t)(w1 & 0xffffu); pp[3 * 4096] = (bf16_t)(w1 >> 16); } }
            } else {
                const float sc = (t == 0 || t == 3) ? 0.125f : 1.0f;
#pragma unroll
                for (int ai = 0; ai < 2; ++ai)
#pragma unroll
                    for (int m = 0; m < 4; ++m) { bf16_t* rowp = base + (size_t)(row0 + ai * HALF + m * 16) * 512 + colt;
#pragma unroll
                        for (int bj = 0; bj < 2; ++bj) { const f32x4 v0 = acc[ai][bj][m][0] * sc, v1 = acc[ai][bj][m][1] * sc;
                            u32x4 w; w.x = cvt_pk_bf16(v0[0], v0[1]); w.y = cvt_pk_bf16(v0[2], v0[3]); w.z = cvt_pk_bf16(v1[0], v1[1]); w.w = cvt_pk_bf16(v1[2], v1[3]);
                            *(u32x4*)(rowp + bj * HALF) = w; } }
            }
        } else {
            const int gc0 = (pn - 12) * 256 + wc * 32 + 8 * fq;
            f32x4 bv[2][2];
#pragma unroll
            for (int bj = 0; bj < 2; ++bj)
#pragma unroll
                for (int n = 0; n < 2; ++n) bv[bj][n] = *(const f32x4*)(bgate + gc0 + bj * HALF + 4 * n);
#pragma unroll
            for (int ai = 0; ai < 2; ++ai)
#pragma unroll
                for (int m = 0; m < 4; ++m) { bf16_t* rowp = gates + (size_t)(row0 + ai * HALF + m * 16) * 2048 + gc0;
#pragma unroll
                    for (int bj = 0; bj < 2; ++bj) { const f32x4 v0 = acc[ai][bj][m][0] + bv[bj][0], v1 = acc[ai][bj][m][1] + bv[bj][1];
                        u32x4 w; w.x = cvt_pk_bf16(sigmoid_f(v0[0]), sigmoid_f(v0[1])); w.y = cvt_pk_bf16(sigmoid_f(v0[2]), sigmoid_f(v0[3]));
                        w.z = cvt_pk_bf16(sigmoid_f(v1[0]), sigmoid_f(v1[1])); w.w = cvt_pk_bf16(sigmoid_f(v1[2]), sigmoid_f(v1[3]));
                        *(u32x4*)(rowp + bj * HALF) = w; } }
        }
    }
};

struct EpiMerge {
    static constexpr bool PERM = true, AFTER_DRAIN = false;
    const bf16_t* gates; float* T; bf16_t* merged;
    __device__ __forceinline__ void operator()(const f32x4 (&acc)[2][2][4][2], const Unit& u, int wr, int wc, int fr, int fq) const {
        const bool ca = u.pm >= 128; const int pm = u.pm & 127, pn = u.pn & 3;
        const int row0 = pm * BM + wr * 64 + fr, col0 = pn * BM + wc * 32 + 8 * fq;
        const bf16_t* gb = gates + (ca ? 1024 : 0) + col0;
#pragma unroll
        for (int ai = 0; ai < 2; ++ai)
#pragma unroll
            for (int m = 0; m < 4; ++m) { const size_t row = (size_t)(row0 + ai * HALF + m * 16);
#pragma unroll
                for (int bj = 0; bj < 2; ++bj) {
                    const u32x4 gw = *(const u32x4*)(gb + row * 2048 + bj * HALF);
                    f32x4 g0, g1;
                    g0[0] = __uint_as_float(gw.x << 16); g0[1] = __uint_as_float(gw.x & 0xffff0000u); g0[2] = __uint_as_float(gw.y << 16); g0[3] = __uint_as_float(gw.y & 0xffff0000u);
                    g1[0] = __uint_as_float(gw.z << 16); g1[1] = __uint_as_float(gw.z & 0xffff0000u); g1[2] = __uint_as_float(gw.w << 16); g1[3] = __uint_as_float(gw.w & 0xffff0000u);
                    f32x4 v0 = acc[ai][bj][m][0] * g0, v1 = acc[ai][bj][m][1] * g1;
                    float* tp = T + row * 1024 + col0 + bj * HALF;
                    if (!ca) { *(f32x4*)tp = v0; *(f32x4*)(tp + 4) = v1; }
                    else { v0 += *(const f32x4*)tp; v1 += *(const f32x4*)(tp + 4);
                        u32x4 w; w.x = cvt_pk_bf16(v0[0], v0[1]); w.y = cvt_pk_bf16(v0[2], v0[3]); w.z = cvt_pk_bf16(v1[0], v1[1]); w.w = cvt_pk_bf16(v1[2], v1[3]);
                        *(u32x4*)(merged + row * 1024 + col0 + bj * HALF) = w; } } }
    }
};

struct EpiRes {
    static constexpr bool PERM = false, AFTER_DRAIN = false;
    const float* base; float* out; float alpha;
    __device__ __forceinline__ void operator()(const f32x4 (&acc)[2][2][4][2], const Unit& u, int wr, int wc, int fr, int fq) const {
        const int row0 = u.pm * BM + wr * 64 + fr, col0 = u.pn * BM + wc * 32 + 4 * fq;
#pragma unroll
        for (int ai = 0; ai < 2; ++ai)
#pragma unroll
            for (int m = 0; m < 4; ++m) { const size_t off = (size_t)(row0 + ai * HALF + m * 16) * 1024 + col0;
#pragma unroll
                for (int bj = 0; bj < 2; ++bj)
#pragma unroll
                    for (int n = 0; n < 2; ++n) { const f32x4 bs = *(const f32x4*)(base + off + bj * HALF + n * 16); *(f32x4*)(out + off + bj * HALF + n * 16) = bs * alpha + acc[ai][bj][m][n]; } }
    }
};

struct EpiRelu2 {
    static constexpr bool PERM = true, AFTER_DRAIN = false;
    bf16_t* O;
    __device__ __forceinline__ void operator()(const f32x4 (&acc)[2][2][4][2], const Unit& u, int wr, int wc, int fr, int fq) const {
        const int row0 = u.pm * BM + wr * 64 + fr, col0 = u.pn * BM + wc * 32 + 8 * fq;
#pragma unroll
        for (int ai = 0; ai < 2; ++ai)
#pragma unroll
            for (int m = 0; m < 4; ++m) { bf16_t* rowp = O + (size_t)(row0 + ai * HALF + m * 16) * DFF + col0;
#pragma unroll
                for (int bj = 0; bj < 2; ++bj) { f32x4 v0 = acc[ai][bj][m][0], v1 = acc[ai][bj][m][1];
#pragma unroll
                    for (int j = 0; j < 4; ++j) { const float a = fmaxf(v0[j], 0.f), b = fmaxf(v1[j], 0.f); v0[j] = a * a; v1[j] = b * b; }
                    u32x4 w; w.x = cvt_pk_bf16(v0[0], v0[1]); w.y = cvt_pk_bf16(v0[2], v0[3]); w.z = cvt_pk_bf16(v1[0], v1[1]); w.w = cvt_pk_bf16(v1[2], v1[3]);
                    *(u32x4*)(rowp + bj * HALF) = w; } }
    }
};

template <class Epi, class Sched, bool ALIGN_EPI = false, bool SP2 = false>
__device__ __forceinline__ void gemm_phase(PG8_LAS unsigned char* lds, const Gemm g, const Sched& S, const Epi& E) {
    const int tid = threadIdx.x, wid = __builtin_amdgcn_readfirstlane(tid >> 6), lane = tid & 63, wr = wid >> 2, wc = wid & 3, fr = lane & 15, fq = lane >> 4;
    const int K = g.K, nt = K / BK;
    unsigned voffA[2], voffB[2];
#pragma unroll
    for (int i = 0; i < 2; ++i) { int R, C; stage_rc(tid * 16 + i * 8192, R, C); const int Rb = Epi::PERM ? ((R & ~31) + perm32(R & 31)) : R;
        voffA[i] = (unsigned)(R * K + C) * 2u; voffB[i] = (unsigned)(Rb * K + C) * 2u; }
    const size_t kstep = (size_t)(BK * 2);
    const size_t hstep = (size_t)HALF * K * 2;
    const size_t tstep = 2 * hstep;
    const unsigned ldsw = (unsigned)wid * 1024u;
    const int aoff = lds_byte(wr * 64 + fr, fq * 8), boff = lds_byte(wc * 32 + fr, fq * 8);
#define PG8_SA(b, h) (((b) * 2 + (h)) * HTB)
#define PG8_SB(b, h) ((4 + (b) * 2 + (h)) * HTB)
#define PG8_STAGE(bufoff, gbase, voff) do { _Pragma("unroll") for (int _i = 0; _i < 2; ++_i) \
        __builtin_amdgcn_global_load_lds((const unsigned*)((const char*)(gbase) + (voff)[_i]), (PG8_LAS unsigned*)(lds + (bufoff) + ldsw + _i * 8192), 16, 0, 0); } while (0)
#define PG8_LDA(dst, b, h) do { _Pragma("unroll") for (int m = 0; m < 4; ++m) _Pragma("unroll") for (int k = 0; k < 2; ++k) dst[m][k] = *(const PG8_LAS bf16x8*)(lds + PG8_SA(b, h) + aoff + m * 2048 + k * 1024); } while (0)
#define PG8_LDB(dst, b, h) do { _Pragma("unroll") for (int n = 0; n < 2; ++n) _Pragma("unroll") for (int k = 0; k < 2; ++k) dst[n][k] = *(const PG8_LAS bf16x8*)(lds + PG8_SB(b, h) + boff + n * 2048 + k * 1024); } while (0)
#define PG8_MMA(ai, bj, At, Bt) do { __builtin_amdgcn_s_setprio(1); _Pragma("unroll") for (int m = 0; m < 4; ++m) _Pragma("unroll") for (int n = 0; n < 2; ++n) _Pragma("unroll") for (int k = 0; k < 2; ++k) \
        acc[ai][bj][m][n] = __builtin_amdgcn_mfma_f32_16x16x32_bf16(Bt[n][k], At[m][k], acc[ai][bj][m][n], 0, 0, 0); __builtin_amdgcn_s_setprio(0); } while (0)
#define PG8_WAIT_V(n) asm volatile("s_waitcnt vmcnt(" #n ")" ::: "memory")
#define PG8_WAIT_L(n) asm volatile("s_waitcnt lgkmcnt(" #n ")" ::: "memory")
#define PG8_BAR __builtin_amdgcn_s_barrier()
#define PG8_SCHED __builtin_amdgcn_sched_barrier(0)
    Unit cur, nxt; int ui = 0;
    if (!S.next(0, cur)) return;
    f32x4 acc[2][2][4][2];
#pragma unroll
    for (int a = 0; a < 2; ++a)
#pragma unroll
        for (int b = 0; b < 2; ++b)
#pragma unroll
            for (int m = 0; m < 4; ++m)
#pragma unroll
                for (int n = 0; n < 2; ++n) acc[a][b][m][n] = (f32x4){0.f, 0.f, 0.f, 0.f};
    bf16x8 At[4][2], B0[2][2], B1[2][2];
    const char* cA = (const char*)g.A + (size_t)cur.pm * tstep; const char* cB = (const char*)g.Bt + (size_t)cur.pn * tstep;
    S.a_ready(cur);
    if constexpr (SP2) {
        PG8_STAGE(PG8_SB(0, 0), cB, voffB); PG8_STAGE(PG8_SB(0, 1), cB + hstep, voffB); PG8_STAGE(PG8_SA(0, 0), cA, voffA); PG8_STAGE(PG8_SA(0, 1), cA + hstep, voffA);
        if (wr == 1) PG8_BAR;
        PG8_WAIT_V(2); PG8_BAR;
        PG8_STAGE(PG8_SB(1, 0), cB + kstep, voffB); PG8_STAGE(PG8_SA(1, 0), cA + kstep, voffA); PG8_STAGE(PG8_SB(1, 1), cB + hstep + kstep, voffB);
        PG8_WAIT_V(6); PG8_BAR;
    } else {
        PG8_STAGE(PG8_SB(0, 0), cB, voffB); PG8_STAGE(PG8_SA(0, 0), cA, voffA); PG8_STAGE(PG8_SB(0, 1), cB + hstep, voffB); PG8_STAGE(PG8_SA(0, 1), cA + hstep, voffA);
        if (wr == 1) PG8_BAR;
        PG8_WAIT_V(4); PG8_BAR;
        PG8_STAGE(PG8_SB(1, 0), cB + kstep, voffB); PG8_STAGE(PG8_SA(1, 0), cA + kstep, voffA); PG8_STAGE(PG8_SB(1, 1), cB + hstep + kstep, voffB);
        PG8_WAIT_V(6); PG8_BAR;
    }
    for (;;) {
        const bool has_next = S.next(ui + 1, nxt);
        const char* nA = has_next ? (const char*)g.A + (size_t)nxt.pm * tstep : cA; const char* nB = has_next ? (const char*)g.Bt + (size_t)nxt.pn * tstep : cB;
        for (int t = 0; t < nt; t += 2) {
            const bool last = (t == nt - 2);
            const char* a1 = cA + (size_t)(t + 1) * kstep;
            const char* a2 = last ? nA : cA + (size_t)(t + 2) * kstep; const char* b2 = last ? nB : cB + (size_t)(t + 2) * kstep;
            const char* a3 = a2 + kstep; const char* b3 = b2 + kstep;
            if (last && has_next) S.a_ready(nxt);
            if constexpr (SP2) {
            PG8_LDB(B0, 0, 0); PG8_LDB(B1, 0, 1); PG8_SCHED; PG8_LDA(At, 0, 0); PG8_STAGE(PG8_SA(1, 1), a1 + hstep, voffA);
            PG8_WAIT_V(8); PG8_WAIT_L(0); PG8_BAR; PG8_MMA(0, 0, At, B0); PG8_MMA(0, 1, At, B1); PG8_BAR; PG8_SCHED;
            PG8_LDA(At, 0, 1); PG8_STAGE(PG8_SB(0, 0), b2, voffB); PG8_STAGE(PG8_SB(0, 1), b2 + hstep, voffB); PG8_STAGE(PG8_SA(0, 0), a2, voffA);
            PG8_WAIT_V(8); PG8_WAIT_L(0); PG8_BAR; PG8_MMA(1, 0, At, B0); PG8_MMA(1, 1, At, B1); PG8_BAR; PG8_SCHED;
            PG8_LDB(B0, 1, 0); PG8_LDB(B1, 1, 1); PG8_SCHED; PG8_LDA(At, 1, 0); PG8_STAGE(PG8_SA(0, 1), a2 + hstep, voffA);
            PG8_WAIT_V(8); PG8_WAIT_L(0); PG8_BAR; PG8_MMA(0, 0, At, B0); PG8_MMA(0, 1, At, B1); PG8_BAR; PG8_SCHED;
            PG8_LDA(At, 1, 1); PG8_STAGE(PG8_SB(1, 0), b3, voffB); PG8_STAGE(PG8_SB(1, 1), b3 + hstep, voffB); PG8_STAGE(PG8_SA(1, 0), a3, voffA);
            PG8_WAIT_V(8); PG8_WAIT_L(0); PG8_BAR; PG8_MMA(1, 0, At, B0); PG8_MMA(1, 1, At, B1); PG8_BAR; PG8_SCHED;
            } else {
            PG8_LDB(B0, 0, 0); PG8_SCHED; PG8_LDA(At, 0, 0); PG8_STAGE(PG8_SA(1, 1), a1 + hstep, voffA);
            PG8_WAIT_L(8); PG8_BAR; PG8_WAIT_L(0); PG8_MMA(0, 0, At, B0); PG8_BAR; PG8_SCHED;
            PG8_LDB(B1, 0, 1); PG8_STAGE(PG8_SB(0, 0), b2, voffB);
            PG8_BAR; PG8_WAIT_L(0); PG8_MMA(0, 1, At, B1); PG8_BAR;
            PG8_LDA(At, 0, 1); PG8_STAGE(PG8_SA(0, 0), a2, voffA);
            PG8_BAR; PG8_WAIT_L(0); PG8_MMA(1, 0, At, B0); PG8_BAR; PG8_SCHED;
            PG8_STAGE(PG8_SB(0, 1), b2 + hstep, voffB);
            PG8_WAIT_V(6); PG8_BAR; PG8_MMA(1, 1, At, B1); PG8_BAR;
            PG8_LDB(B0, 1, 0); PG8_SCHED; PG8_LDA(At, 1, 0); PG8_STAGE(PG8_SA(0, 1), a2 + hstep, voffA);
            PG8_WAIT_L(8); PG8_BAR; PG8_WAIT_L(0); PG8_MMA(0, 0, At, B0); PG8_BAR; PG8_SCHED;
            PG8_LDB(B1, 1, 1); PG8_STAGE(PG8_SB(1, 0), b3, voffB);
            PG8_BAR; PG8_WAIT_L(0); PG8_MMA(0, 1, At, B1); PG8_BAR;
            PG8_LDA(At, 1, 1); PG8_STAGE(PG8_SA(1, 0), a3, voffA);
            PG8_BAR; PG8_WAIT_L(0); PG8_MMA(1, 0, At, B0); PG8_BAR; PG8_SCHED;
            PG8_STAGE(PG8_SB(1, 1), b3 + hstep, voffB);
            PG8_WAIT_V(6); PG8_BAR; PG8_MMA(1, 1, At, B1); PG8_BAR;
            }
        }
        if constexpr (ALIGN_EPI) { if (wr == 0) PG8_BAR; }
        if constexpr (!Epi::AFTER_DRAIN) { E(acc, cur, wr, wc, fr, fq); S.done(cur); }
        if (!has_next) break;
#pragma unroll
        for (int a = 0; a < 2; ++a)
#pragma unroll
            for (int b = 0; b < 2; ++b)
#pragma unroll
                for (int m = 0; m < 4; ++m)
#pragma unroll
                    for (int n = 0; n < 2; ++n) acc[a][b][m][n] = (f32x4){0.f, 0.f, 0.f, 0.f};
        cur = nxt; cA = nA; cB = nB; ++ui;
        if constexpr (ALIGN_EPI) { if (wr == 1) PG8_BAR; }
    }
    PG8_WAIT_V(0);
    if constexpr (!ALIGN_EPI) { if (wr == 0) PG8_BAR; }
    PG8_BAR;
    if constexpr (Epi::AFTER_DRAIN) { E.fused(acc, cur, wr, wc, fr, fq, lds, wid, lane); S.done(cur); }
#undef PG8_SA
#undef PG8_SB
#undef PG8_STAGE
#undef PG8_LDA
#undef PG8_LDB
#undef PG8_MMA
#undef PG8_WAIT_V
#undef PG8_WAIT_L
#undef PG8_BAR
#undef PG8_SCHED
}
}

#define GAS __attribute__((address_space(1)))
#define LAS __attribute__((address_space(3)))
typedef unsigned short bf16;
typedef unsigned v4u __attribute__((ext_vector_type(4)));
typedef unsigned v2u __attribute__((ext_vector_type(2)));
typedef float f32x4 __attribute__((ext_vector_type(4)));
typedef float f32x16 __attribute__((ext_vector_type(16)));
typedef short bf16x8 __attribute__((ext_vector_type(8)));
typedef short s16x4 __attribute__((ext_vector_type(4)));
constexpr int NWAVES = 8;
constexpr float LN_EPS = 1e-5f;
constexpr float DN_ALPHA = 1.189207115002721f;
constexpr int LDS_BYTES = 147456;
#define LDS_WAIT() asm volatile("s_waitcnt lgkmcnt(0)" ::: "memory")

constexpr size_t MiB = 1u << 20;
constexpr size_t WS_W_IN = 2 * MiB, WS_W_SC = 12 * MiB, WS_W_OUT = 14 * MiB, WS_W_MI = 16 * MiB, WS_W_MO = 24 * MiB;
constexpr size_t WS_XB = 32 * MiB;
constexpr size_t WS_QKV = 96 * MiB;
constexpr size_t WS_GATES = 288 * MiB;
constexpr size_t WS_O2 = 416 * MiB;
constexpr size_t WS_T = 96 * MiB;
constexpr size_t WS_MERGED = 224 * MiB;
constexpr size_t WS_H = 96 * MiB;
constexpr size_t WS_END = 480 * MiB;
constexpr size_t WS_CTL = 0, CTL_ZERO_BYTES = 16384;
constexpr int BAR_LDS_OFF = 131072 + 512;

__device__ __forceinline__ float wave_sum(float v) {
#pragma unroll
    for (int o = 1; o < 64; o <<= 1) v += __shfl_xor(v, o);
    return v;
}
__device__ __forceinline__ unsigned pk2(float lo, float hi) { return pg8::cvt_pk_bf16(lo, hi); }

__device__ __forceinline__ void p0_transpose_item(const float* W, int K, int N, bf16* WT, int row_off, LAS float* scr, int item, int lane) {
    const int nblk = N / 32, kb = item / nblk, nb = item % nblk, k0 = 64 * kb, n0 = 32 * nb;
#pragma unroll 8
    for (int i = 0; i < 32; ++i) { const int kk = 2 * i + (lane >> 5); scr[kk * 33 + (lane & 31)] = W[(size_t)(k0 + kk) * N + n0 + (lane & 31)]; }
    LDS_WAIT(); asm volatile("" ::: "memory");
    const int c = lane & 7;
#pragma unroll
    for (int j = 0; j < 4; ++j) { const int n = (lane >> 3) + 8 * j; const LAS float* s = scr + (8 * c) * 33 + n;
        v4u o; o.x = pk2(s[0 * 33], s[1 * 33]); o.y = pk2(s[2 * 33], s[3 * 33]); o.z = pk2(s[4 * 33], s[5 * 33]); o.w = pk2(s[6 * 33], s[7 * 33]);
        *(GAS v4u*)(WT + (size_t)(row_off + n0 + n) * K + k0 + 8 * c) = o; }
    LDS_WAIT(); asm volatile("" ::: "memory");
}

__device__ __forceinline__ void row_to_bf16(const float* xrow, bf16* orow, int lane) {
    const f32x4* xr = (const f32x4*)xrow + lane; v2u* o8 = (v2u*)orow + lane;
#pragma unroll
    for (int j = 0; j < 4; ++j) { const f32x4 v = xr[64 * j]; v2u w; w.x = pk2(v[0], v[1]); w.y = pk2(v[2], v[3]); o8[64 * j] = w; }
}
__device__ __forceinline__ void ln_row(float* row, bf16* brow, const float* g, const float* bta, int lane) {
    f32x4* xr = (f32x4*)row + lane; f32x4 v[4]; float s = 0.f;
#pragma unroll
    for (int j = 0; j < 4; ++j) { v[j] = xr[64 * j]; s += (v[j][0] + v[j][1]) + (v[j][2] + v[j][3]); }
    const float mean = wave_sum(s) * (1.f / 1024.f); float s2 = 0.f;
#pragma unroll
    for (int j = 0; j < 4; ++j) { v[j] = v[j] - mean; s2 += (v[j][0] * v[j][0] + v[j][1] * v[j][1]) + (v[j][2] * v[j][2] + v[j][3] * v[j][3]); }
    const float rstd = 1.f / sqrtf(wave_sum(s2) * (1.f / 1024.f) + LN_EPS);
#pragma unroll
    for (int j = 0; j < 4; ++j) { const f32x4 gg = ((const f32x4*)g)[lane + 64 * j], bb = ((const f32x4*)bta)[lane + 64 * j]; const f32x4 y = v[j] * rstd * gg + bb; xr[64 * j] = y;
        if (brow) { v2u w; w.x = pk2(y[0], y[1]); w.y = pk2(y[2], y[3]); ((v2u*)brow)[lane + 64 * j] = w; } }
}

#define XB_TMO      128
#define XB_XCNT(j)  (256  + 64 * (j))
#define XB_XSUB(j)  (1280 + 64 * (j))
#define XB_XGEN(j)  (2304 + 64 * (j))
#define XB_TOP      3328
#define XB_TOPGEN   3392
#define XCD_BAR_WORDS 3456
#define XB_SPIN_CAP (1u << 18)

__device__ __forceinline__ unsigned xb_ld(unsigned* p)              { return __hip_atomic_load(p, __ATOMIC_RELAXED, __HIP_MEMORY_SCOPE_AGENT); }
__device__ __forceinline__ unsigned xb_add(unsigned* p, unsigned v) { return __hip_atomic_fetch_add(p, v, __ATOMIC_RELAXED, __HIP_MEMORY_SCOPE_AGENT); }
__device__ __forceinline__ unsigned xb_xcc_id() { return (unsigned)__builtin_amdgcn_s_getreg((3 << 11) | 20) & 0xFu; }
#define XB_SPIN(cond, bar) do { unsigned _sp = 0; while (cond) { __builtin_amdgcn_s_sleep(1); \
    if ((++_sp & 255u) == 0u) { if (xb_ld(&(bar)[XB_TMO])) break; if (_sp > XB_SPIN_CAP) { atomicAdd(&(bar)[XB_TMO], 1u); break; } } } } while (0)

struct XcdBarrier {
    unsigned* bar; unsigned x;
    volatile LAS unsigned* st;
};

__device__ __forceinline__ XcdBarrier xcd_barrier_post(unsigned* bar, volatile LAS unsigned* st) {
    XcdBarrier b; b.bar = bar; b.x = xb_xcc_id(); b.st = st;
    if (threadIdx.x == 0) (void)xb_add(&bar[XB_XCNT(b.x)], 1u);
    return b;
}
__device__ __forceinline__ void xcd_barrier_complete(unsigned* bar, unsigned x, unsigned& nloc, unsigned& nx) {
    const unsigned G = gridDim.x * gridDim.y * gridDim.z;
    unsigned sum, cnt, mine, sp = 0u;
    for (;;) {
        sum = 0u; cnt = 0u; mine = 0u;
#pragma unroll
        for (unsigned j = 0; j < 16; ++j) { const unsigned c = xb_ld(&bar[XB_XCNT(j)]); sum += c; cnt += (c > 0u) ? 1u : 0u; mine = (j == x) ? c : mine; }
        if (sum == G) break;
        __builtin_amdgcn_s_sleep(1);
        if ((++sp & 255u) == 0u) { if (xb_ld(&bar[XB_TMO])) break; if (sp > XB_SPIN_CAP) { atomicAdd(&bar[XB_TMO], 1u); break; } }
    }
    nloc = mine > 0u ? mine : 1u; nx = cnt > 0u ? cnt : 1u;
}

__device__ __forceinline__ void xcd_barrier(const XcdBarrier& b) {
    asm volatile("s_waitcnt vmcnt(0)" ::: "memory");
    __syncthreads();
    if (threadIdx.x == 0) {
        unsigned* bar = b.bar;
        __builtin_amdgcn_s_waitcnt(0);
        unsigned nloc = b.st[0], nx = b.st[1];
        if (nloc == 0u) { xcd_barrier_complete(bar, b.x, nloc, nx); b.st[0] = nloc; b.st[1] = nx; }
        const unsigned old = xb_add(&bar[XB_XSUB(b.x)], 1u);
        const unsigned gen = old / nloc;
        if (old + 1u == (gen + 1u) * nloc) {
            __builtin_amdgcn_fence(__ATOMIC_RELEASE, "agent");
            asm volatile("s_waitcnt vmcnt(0)" ::: "memory");
            const unsigned og = xb_add(&bar[XB_TOP], 1u);
            const unsigned tg = og / nx;
            if (og + 1u == (tg + 1u) * nx) xb_add(&bar[XB_TOPGEN], 1u);
            else XB_SPIN(xb_ld(&bar[XB_TOPGEN]) == tg, bar);
            __builtin_amdgcn_fence(__ATOMIC_ACQUIRE, "agent");
            xb_add(&bar[XB_XGEN(b.x)], 1u);
            asm volatile("s_waitcnt vmcnt(0)" ::: "memory");
        } else {
            XB_SPIN(xb_ld(&bar[XB_XGEN(b.x)]) == gen, bar);
            __builtin_amdgcn_fence(__ATOMIC_ACQUIRE, "agent");
            asm volatile("s_waitcnt vmcnt(0)" ::: "memory");
        }
    }
    __syncthreads();
}

#define MFMA32(a, b, c) __builtin_amdgcn_mfma_f32_32x32x16_bf16((a), (b), (c), 0, 0, 0)
__device__ __forceinline__ int crow(int reg, int h) { return (reg & 3) + 8 * (reg >> 2) + 4 * h; }
__device__ __forceinline__ void load_frag4(bf16x8 (&f)[4], const bf16* p, int r, int hi) {
    const bf16x8* q = (const bf16x8*)(p + (size_t)r * 512 + 8 * hi);
#pragma unroll
    for (int s = 0; s < 4; ++s) f[s] = q[2 * s];
}
__device__ __forceinline__ void load_vt(bf16x8 (&v)[2][2], const bf16* p, int r, int hi) {
#pragma unroll
    for (int db = 0; db < 2; ++db)
#pragma unroll
        for (int s = 0; s < 2; ++s) { const s16x4* q = (const s16x4*)(p + (size_t)(db * 32 + r) * 4096 + 16 * s + 4 * hi); const s16x4 lo = q[0], hh = q[2];
            v[db][s] = __builtin_shufflevector(lo, hh, 0, 1, 2, 3, 4, 5, 6, 7); }
}
__device__ __forceinline__ bf16x8 pack8(const float (&p)[16], int s) {
    v4u w; w.x = pk2(p[8 * s], p[8 * s + 1]); w.y = pk2(p[8 * s + 2], p[8 * s + 3]); w.z = pk2(p[8 * s + 4], p[8 * s + 5]); w.w = pk2(p[8 * s + 6], p[8 * s + 7]);
    return __builtin_bit_cast(bf16x8, w);
}
__device__ __forceinline__ void store_o(bf16* orow  , const f32x16& o0, const f32x16& o1, float sc, int hi) {
#pragma unroll
    for (int g = 0; g < 4; ++g) { v2u w0, w1;
        w0.x = pk2(o0[4 * g] * sc, o0[4 * g + 1] * sc); w0.y = pk2(o0[4 * g + 2] * sc, o0[4 * g + 3] * sc);
        w1.x = pk2(o1[4 * g] * sc, o1[4 * g + 1] * sc); w1.y = pk2(o1[4 * g + 2] * sc, o1[4 * g + 3] * sc);
        *(v2u*)(orow + 8 * g + 4 * hi) = w0; *(v2u*)(orow + 32 + 8 * g + 4 * hi) = w1; }
}

__device__ __forceinline__ void sb_unit(const bf16* Q, const bf16* K, const bf16* VT, bf16* O, int bh, int qb, int lane) {
    const int r = lane & 31, hi = lane >> 5, b = bh >> 3, h = bh & 7;
    const size_t rowbase = (size_t)b * SEQL;
    const bf16* Kh = K + rowbase * 512 + h * 64;
    const bf16* VTh = VT + (size_t)bh * 64 * 4096;
    bf16x8 qf[4], kf[4];
    load_frag4(qf, Q + (rowbase + qb * 32) * 512 + h * 64, r, hi);
    load_frag4(kf, Kh + (size_t)(qb * 32) * 512, r, hi);
    f32x16 o0, o1;
#pragma unroll
    for (int i = 0; i < 16; ++i) { o0[i] = 0.f; o1[i] = 0.f; }
    float R = 0.f;
    for (int kb = qb; kb >= 0; --kb) {
        bf16x8 vf[2][2], kn[4];
        load_vt(vf, VTh + kb * 32, r, hi);
        load_frag4(kn, Kh + (size_t)((kb > 0 ? kb - 1 : 0) * 32) * 512, r, hi);
        f32x16 z;
#pragma unroll
        for (int i = 0; i < 16; ++i) z[i] = 0.f;
#pragma unroll
        for (int s = 0; s < 4; ++s) z = MFMA32(kf[s], qf[s], z);
        const bool diag = (kb == qb);
        float lk[16], ls[16], G[4];
#pragma unroll
        for (int g = 0; g < 4; ++g) G[g] = 0.f;
#pragma unroll
        for (int i = 0; i < 16; ++i) {
            const float zi = z[i];
            const bool valid = !diag || (crow(i, hi) < r);
            const float sp = fmaxf(zi, 0.f) + __logf(1.0f + __expf(-fabsf(zi)));
            lk[i] = valid ? -sp : 0.f;
            ls[i] = valid ? (zi - sp) : -INFINITY;
            G[i >> 2] += lk[i];
        }
        float Hh[4], A[4];
#pragma unroll
        for (int g = 0; g < 4; ++g) Hh[g] = __shfl_xor(G[g], 32);
        float run = 0.f;
#pragma unroll
        for (int g = 3; g >= 0; --g) { A[g] = run + (hi ? 0.f : Hh[g]); run += G[g] + Hh[g]; }
        float p[16];
#pragma unroll
        for (int g = 0; g < 4; ++g) { float e = R + A[g];
#pragma unroll
            for (int j = 3; j >= 0; --j) { p[4 * g + j] = __expf(ls[4 * g + j] + e); e += lk[4 * g + j]; } }
        R += run;
        const bf16x8 p0 = pack8(p, 0), p1 = pack8(p, 1);
        o0 = MFMA32(vf[0][0], p0, o0); o0 = MFMA32(vf[0][1], p1, o0);
        o1 = MFMA32(vf[1][0], p0, o1); o1 = MFMA32(vf[1][1], p1, o1);
#pragma unroll
        for (int s = 0; s < 4; ++s) kf[s] = kn[s];
        if (__all(R < -106.0f)) break;
    }
    store_o(O + (rowbase + qb * 32 + r) * 512 + h * 64, o0, o1, 1.0f, hi);
}

__device__ __forceinline__ void ca_unit(const bf16* Q, const bf16* K, const bf16* VT, bf16* O, const LAS float* tab, int bh, int c, int hf, int lane) {
    const int r = lane & 31, hi = lane >> 5, b = bh >> 3, h = bh & 7;
    const size_t rowbase = (size_t)b * SEQL;
    const bf16* Kh = K + rowbase * 512 + h * 64;
    const bf16* VTh = VT + (size_t)bh * 64 * 4096;
    const int t0 = c * 64 + hf * 32;
    const int kb0 = (c > 8 ? c - 8 : 0) * 2, kb1 = (c + 1) * 2;
    bf16x8 qf[4], kf[4];
    load_frag4(qf, Q + (rowbase + t0) * 512 + h * 64, r, hi);
    load_frag4(kf, Kh + (size_t)(kb0 * 32) * 512, r, hi);
    f32x16 o0, o1;
#pragma unroll
    for (int i = 0; i < 16; ++i) { o0[i] = 0.f; o1[i] = 0.f; }
    float mrun = -INFINITY, l = 0.f;
    const float bias_far = tab[512];
    for (int kb = kb0; kb < kb1; ++kb) {
        bf16x8 vf[2][2], kn[4];
        load_vt(vf, VTh + kb * 32, r, hi);
        load_frag4(kn, Kh + (size_t)((kb + 1 < kb1 ? kb + 1 : kb) * 32) * 512, r, hi);
        f32x16 z;
#pragma unroll
        for (int i = 0; i < 16; ++i) z[i] = 0.f;
#pragma unroll
        for (int s = 0; s < 4; ++s) z = MFMA32(kf[s], qf[s], z);
        const int k0 = kb * 32;
        float zz[16];
        if (t0 - (k0 + 31) >= 256) {
#pragma unroll
            for (int i = 0; i < 16; ++i) zz[i] = z[i] + bias_far;
        } else {
            const int d0 = t0 + r - k0 + 256;
#pragma unroll
            for (int i = 0; i < 16; ++i) { int idx = d0 - crow(i, hi); idx = idx < 0 ? 0 : (idx > 512 ? 512 : idx); zz[i] = z[i] + tab[idx]; }
        }
        float mx = zz[0];
#pragma unroll
        for (int i = 1; i < 16; ++i) mx = fmaxf(mx, zz[i]);
        mx = fmaxf(mx, __shfl_xor(mx, 32));
        const float mnew = fmaxf(mrun, mx);
        const float alpha = __expf(mrun - mnew);
        float p[16]; float ps = 0.f;
#pragma unroll
        for (int i = 0; i < 16; ++i) { p[i] = __expf(zz[i] - mnew); ps += p[i]; }
        l = l * alpha + ps; mrun = mnew;
#pragma unroll
        for (int i = 0; i < 16; ++i) { o0[i] *= alpha; o1[i] *= alpha; }
        const bf16x8 p0 = pack8(p, 0), p1 = pack8(p, 1);
        o0 = MFMA32(vf[0][0], p0, o0); o0 = MFMA32(vf[0][1], p1, o0);
        o1 = MFMA32(vf[1][0], p0, o1); o1 = MFMA32(vf[1][1], p1, o1);
#pragma unroll
        for (int s = 0; s < 4; ++s) kf[s] = kn[s];
    }
    l += __shfl_xor(l, 32);
    store_o(O + (rowbase + t0 + r) * 512 + h * 64, o0, o1, 1.0f / l, hi);
}

struct Args { const float* x; const float* w_in; const float* b_gate; const float* w_sb; const float* w_ca; const float* rel_bias; const float* w_out; const float* ln1_g; const float* ln1_b;
              const float* w_mi; const float* w_mo; const float* ln2_g; const float* ln2_b; float* out; unsigned char* ws; };

__global__ void __launch_bounds__(NWAVES * 64, 2) mk_fwd(Args a) {
    extern __shared__ __attribute__((aligned(16))) unsigned char lds_raw[];
    LAS unsigned char* lds = (LAS unsigned char*)lds_raw;
    cg::grid_group grid = cg::this_grid();
    const int tid = threadIdx.x, lane = tid & 63, wave = __builtin_amdgcn_readfirstlane(tid >> 6);
    const int G = gridDim.x, bx = blockIdx.x;
    const int vcu = (G % 8 == 0) ? (bx % 8) * (G / 8) + bx / 8 : bx;
    const int gw = vcu * NWAVES + wave, NGW = G * NWAVES;
    unsigned char* ws = a.ws;
    bf16* W_IN = (bf16*)(ws + WS_W_IN); bf16* W_SC = (bf16*)(ws + WS_W_SC); bf16* W_OUT = (bf16*)(ws + WS_W_OUT); bf16* W_MI = (bf16*)(ws + WS_W_MI); bf16* W_MO = (bf16*)(ws + WS_W_MO);
    bf16* XB = (bf16*)(ws + WS_XB); bf16* QKV = (bf16*)(ws + WS_QKV); bf16* GATES = (bf16*)(ws + WS_GATES); bf16* O2 = (bf16*)(ws + WS_O2);
    float* T = (float*)(ws + WS_T); bf16* MERGED = (bf16*)(ws + WS_MERGED); bf16* HB = (bf16*)(ws + WS_H);
    constexpr size_t QSZ = (size_t)MTOK * 512;
    volatile LAS unsigned* bst = (volatile LAS unsigned*)(lds + BAR_LDS_OFF);
    if (tid < 4) bst[tid] = 0u;
    __syncthreads();
    const XcdBarrier bar = xcd_barrier_post((unsigned*)(ws + WS_CTL), bst);

    {
        LAS float* scr = (LAS float*)(lds + wave * 16384);
        constexpr int I_IN = (DMODEL / 64) * (NINC / 32), I_SB = (WIDTH / 64) * (DMODEL / 32), I_OUT = (DMODEL / 64) * (DMODEL / 32), I_MI = (DMODEL / 64) * (DFF / 32), I_MO = (DFF / 64) * (DMODEL / 32);
        constexpr int NITEMS = I_IN + 2 * I_SB + I_OUT + I_MI + I_MO;
        for (int it = gw; it < NITEMS; it += NGW) {
            int q = it;
            if (q < I_IN) { p0_transpose_item(a.w_in, DMODEL, NINC, W_IN, 0, scr, q, lane); continue; } q -= I_IN;
            if (q < I_SB) { p0_transpose_item(a.w_sb, WIDTH, DMODEL, W_SC, 0, scr, q, lane); continue; } q -= I_SB;
            if (q < I_SB) { p0_transpose_item(a.w_ca, WIDTH, DMODEL, W_SC, DMODEL, scr, q, lane); continue; } q -= I_SB;
            if (q < I_OUT) { p0_transpose_item(a.w_out, DMODEL, DMODEL, W_OUT, 0, scr, q, lane); continue; } q -= I_OUT;
            if (q < I_MI) { p0_transpose_item(a.w_mi, DMODEL, DFF, W_MI, 0, scr, q, lane); continue; } q -= I_MI;
            p0_transpose_item(a.w_mo, DFF, DMODEL, W_MO, 0, scr, q, lane);
        }
        for (int m = gw; m < MTOK; m += NGW) row_to_bf16(a.x + (size_t)m * DMODEL, XB + (size_t)m * DMODEL, lane);
    }
    grid.sync();

    {
        pg8::Gemm g{XB, W_IN, MTOK, NINC, DMODEL}; pg8::StaticOrder S; S.init(MTOK, NINC, G, bx);
        pg8::EpiIn E{QKV, GATES, a.b_gate};
        pg8::gemm_phase<pg8::EpiIn, pg8::StaticOrder, true, true>(lds, g, S, E);
    }
    xcd_barrier(bar);

    {
        LAS float* tab = (LAS float*)lds;
        for (int i = tid; i < NHEADS * 513; i += NWAVES * 64) tab[i] = a.rel_bias[i];
        __syncthreads();
        for (int u = gw; u < 16384; u += NGW) {
            if (u < 8192) { const int bh = u >> 7, qb = u & 127; sb_unit(QKV, QKV + QSZ, QKV + 2 * QSZ, O2, bh, qb, lane); }
            else { const int v = u - 8192, bh = v >> 7, c = (v & 127) >> 1, hf = v & 1; ca_unit(QKV + 3 * QSZ, QKV + 4 * QSZ, QKV + 5 * QSZ, O2 + QSZ, tab + (bh & 7) * 513, bh, c, hf, lane); }
        }
        __syncthreads();
    }
    xcd_barrier(bar);

    {
        pg8::Gemm g{O2, W_SC, 2 * MTOK, 2 * DMODEL, WIDTH}; pg8::MergeOrder S; S.so.init(MTOK, DMODEL, G, bx);
        pg8::EpiMerge E{GATES, T, MERGED};
        pg8::gemm_phase<pg8::EpiMerge, pg8::MergeOrder, true, true>(lds, g, S, E);
    }
    xcd_barrier(bar);

    {
        pg8::Gemm g{MERGED, W_OUT, MTOK, DMODEL, DMODEL}; pg8::StaticOrder S; S.init(MTOK, DMODEL, G, bx);
        pg8::EpiRes E{a.x, a.out, DN_ALPHA};
        pg8::gemm_phase<pg8::EpiRes, pg8::StaticOrder, true, true>(lds, g, S, E);
    }
    xcd_barrier(bar);

    for (int m = gw; m < MTOK; m += NGW) ln_row(a.out + (size_t)m * DMODEL, XB + (size_t)m * DMODEL, a.ln1_g, a.ln1_b, lane);
    xcd_barrier(bar);

    {
        pg8::Gemm g{XB, W_MI, MTOK, DFF, DMODEL}; pg8::StaticOrder S; S.init(MTOK, DFF, G, bx);
        pg8::EpiRelu2 E{HB};
        pg8::gemm_phase<pg8::EpiRelu2, pg8::StaticOrder, true, true>(lds, g, S, E);
    }
    xcd_barrier(bar);

    {
        pg8::Gemm g{HB, W_MO, MTOK, DMODEL, DFF}; pg8::StaticOrder S; S.init(MTOK, DMODEL, G, bx);
        pg8::EpiRes E{a.out, a.out, DN_ALPHA};
        pg8::gemm_phase<pg8::EpiRes, pg8::StaticOrder, true, true>(lds, g, S, E);
    }
    xcd_barrier(bar);

    for (int m = gw; m < MTOK; m += NGW) ln_row(a.out + (size_t)m * DMODEL, nullptr, a.ln2_g, a.ln2_b, lane);
}

extern "C" void kernel_launch(void* const* d_in, const int* in_sizes, int n_in, void* d_out, int out_size, void* d_ws, size_t ws_size, hipStream_t stream) {
    static int grid = 0;
    if (grid == 0) {
        if (n_in != 13 || in_sizes[0] != MTOK * DMODEL || out_size != MTOK * DMODEL || ws_size < WS_END) { fprintf(stderr, "kernel_launch: unexpected shapes (n_in %d, in0 %d, out %d, ws %zu); nothing launched\n", n_in, n_in > 0 ? in_sizes[0] : -1, out_size, ws_size); grid = -1; return; }
        int dev = 0, cus = 0, per_cu = 0;
        if (hipGetDevice(&dev) != hipSuccess || hipDeviceGetAttribute(&cus, hipDeviceAttributeMultiprocessorCount, dev) != hipSuccess) { fprintf(stderr, "kernel_launch: device query failed\n"); grid = -1; return; }
        if (hipFuncSetAttribute((const void*)mk_fwd, hipFuncAttributeMaxDynamicSharedMemorySize, LDS_BYTES) != hipSuccess) { fprintf(stderr, "kernel_launch: hipFuncSetAttribute failed\n"); grid = -1; return; }
        if (hipOccupancyMaxActiveBlocksPerMultiprocessor(&per_cu, (const void*)mk_fwd, NWAVES * 64, LDS_BYTES) != hipSuccess || per_cu < 1) { fprintf(stderr, "kernel_launch: occupancy query says %d blocks per CU\n", per_cu); per_cu = 1; }
        (void)hipGetLastError();
        grid = cus * 1;
    }
    if (grid < 0) return;
    if (hipMemsetAsync((char*)d_ws + WS_CTL, 0, CTL_ZERO_BYTES, stream) != hipSuccess) { fprintf(stderr, "kernel_launch: memset failed\n"); return; }
    Args a{};
    a.x = (const float*)d_in[0]; a.w_in = (const float*)d_in[1]; a.b_gate = (const float*)d_in[2]; a.w_sb = (const float*)d_in[3]; a.w_ca = (const float*)d_in[4]; a.rel_bias = (const float*)d_in[5];
    a.w_out = (const float*)d_in[6]; a.ln1_g = (const float*)d_in[7]; a.ln1_b = (const float*)d_in[8]; a.w_mi = (const float*)d_in[9]; a.w_mo = (const float*)d_in[10]; a.ln2_g = (const float*)d_in[11]; a.ln2_b = (const float*)d_in[12];
    a.out = (float*)d_out; a.ws = (unsigned char*)d_ws;
    void* args[] = {&a};
    const hipError_t e = hipLaunchCooperativeKernel((const void*)mk_fwd, dim3(grid), dim3(NWAVES * 64), args, LDS_BYTES, stream);
    if (e != hipSuccess) fprintf(stderr, "kernel_launch: cooperative launch failed: %s (grid %d)\n", hipGetErrorString(e), grid);
}
```

```cpp
#include <hip/hip_runtime.h>
#include <hip/hip_cooperative_groups.h>
#include <cstdio>
#include <cstdint>
namespace cg = cooperative_groups;
constexpr int MTOK = 32768, DMODEL = 1024, SEQL = 4096, NBATCH = 8, NHEADS = 8, WIDTH = 512, DFF = 4096, NINC = 5120;
namespace pg8 {
#define PG8_LAS __attribute__((address_space(3)))
typedef unsigned short bf16_t;
typedef short bf16x8 __attribute__((ext_vector_type(8)));
typedef float f32x4 __attribute__((ext_vector_type(4)));
typedef unsigned u32x4 __attribute__((ext_vector_type(4)));
constexpr int BM = 256, BK = 64, HALF = 128, HTB = HALF * BK * 2  , STAGE_BYTES = 8 * HTB, NXCD = 8, WGM = 8;

__host__ __device__ __forceinline__ int lds_byte(int r, int c) { const int st = (r >> 4) * 2 + (c >> 5), rr = r & 15, cc = c & 31, ob = rr * 64 + cc * 2; return st * 1024 + (ob ^ (((ob >> 9) & 1) << 5)); }
__host__ __device__ __forceinline__ void stage_rc(int b, int& R, int& C) { const int st = b / 1024, sb = b % 1024, swz = sb ^ (((sb >> 9) & 1) << 5); R = (st >> 1) * 16 + swz / 64; C = (st & 1) * 32 + (swz % 64) / 2; }
__host__ __device__ __forceinline__ int perm32(int rho) { const int n = rho >> 4, i = rho & 15; return 8 * (i >> 2) + 4 * n + (i & 3); }

struct Unit { int pm, pn; };
struct Gemm { const bf16_t* A; const bf16_t* Bt; int M, N, K; };

struct StaticOrder {
    int nM, nN, nwg, G, c;
    __host__ __device__ void init(int M, int N, int G_, int c_) { nM = M / BM; nN = N / BM; nwg = nM * nN; G = G_; c = c_; }
    __host__ __device__ bool next(int i, Unit& u) const {
        const long L = (long)i * G + c; if (L >= nwg) return false;
        int wgid = (int)L; { const int q = nwg / NXCD, r = nwg % NXCD, xcd = wgid % NXCD, off = wgid / NXCD; wgid = (xcd < r ? xcd * (q + 1) : r * (q + 1) + (xcd - r) * q) + off; }
        const int nig = WGM * nN, gid = wgid / nig, fm = gid * WGM, gsz = (nM - fm) < WGM ? (nM - fm) : WGM;
        u.pm = fm + ((wgid % nig) % gsz); u.pn = (wgid % nig) / gsz; return true;
    }
    __device__ __forceinline__ void a_ready(const Unit&) const {}
    __device__ __forceinline__ void done(const Unit&) const {}
};
typedef float f32x2 __attribute__((ext_vector_type(2)));
typedef __bf16 bf16x2_t __attribute__((ext_vector_type(2)));
__device__ __forceinline__ unsigned cvt_pk_bf16(float lo, float hi) { f32x2 v = {lo, hi}; bf16x2_t b = __builtin_convertvector(v, bf16x2_t); return __builtin_bit_cast(unsigned, b); }
__device__ __forceinline__ float sigmoid_f(float v) { return __builtin_amdgcn_rcpf(1.0f + __expf(-v)); }

struct MergeOrder {
    StaticOrder so;
    __host__ __device__ bool next(int i, Unit& u) const { Unit b; if (!so.next(i >> 1, b)) return false; if (i & 1) { u.pm = b.pm + 128; u.pn = b.pn + 4; } else { u = b; } return true; }
    __device__ __forceinline__ void a_ready(const Unit&) const {}
    __device__ __forceinline__ void done(const Unit&) const {}
};

struct EpiIn {
    static constexpr bool PERM = true, AFTER_DRAIN = false;
    bf16_t* qkv;
    bf16_t* gates;
    const float* bgate;
    __device__ __forceinline__ void operator()(const f32x4 (&acc)[2][2][4][2], const Unit& u, int wr, int wc, int fr, int fq) const {
        const int pn = u.pn; const int row0 = u.pm * BM + wr * 64 + fr;
        if (pn < 12) {
            const int t = pn >> 1; bf16_t* base = qkv + (size_t)t * ((size_t)MTOK * 512);
            const int colt = (pn & 1) * 256 + wc * 32 + 8 * fq;
            if (t == 2 || t == 5) {
#pragma unroll
                for (int ai = 0; ai < 2; ++ai)
#pragma unroll
                    for (int m = 0; m < 4; ++m) { const int row = row0 + ai * HALF + m * 16; const int b = row >> 12, tt = row & 4095;
                        const int kb = tt >> 5, s = (tt >> 4) & 1, k16 = tt & 15, hi = (k16 >> 2) & 1, j = ((k16 >> 3) << 2) | (k16 & 3);
#pragma unroll
                        for (int bj = 0; bj < 2; ++bj) { const int col = colt + bj * HALF, h = col >> 6, d0 = col & 63, db = d0 >> 5, r0 = d0 & 31;
                            bf16_t* pp = base + ((((((size_t)(b * 8 + h) * 128 + kb) * 2 + db) * 2 + s) * 64 + hi * 32 + r0) * 8 + j);
#pragma unroll
                            for (int n = 0; n < 2; ++n) { const f32x4 v = acc[ai][bj][m][n]; const unsigned w0 = cvt_pk_bf16(v[0], v[1]), w1 = cvt_pk_bf16(v[2], v[3]);
                                pp[(4 * n) * 8] = (bf16_t)(w0 & 0xffffu); pp[(4 * n + 1) * 8] = (bf16_t)(w0 >> 16); pp[(4 * n + 2) * 8] = (bf16_t)(w1 & 0xffffu); pp[(4 * n + 3) * 8] = (bf16_t)(w1 >> 16); } } }
            } else {
                const float sc = (t == 0 || t == 3) ? 0.125f : 1.0f;
#pragma unroll
                for (int ai = 0; ai < 2; ++ai)
#pragma unroll
                    for (int m = 0; m < 4; ++m) { const int row = row0 + ai * HALF + m * 16; const int b = row >> 12, tt = row & 4095, blk = tt >> 5, r = tt & 31;
#pragma unroll
                        for (int bj = 0; bj < 2; ++bj) { const int col = colt + bj * HALF, h = col >> 6, d0 = col & 63, s = d0 >> 4, hi = (d0 >> 3) & 1;
                            const f32x4 v0 = acc[ai][bj][m][0] * sc, v1 = acc[ai][bj][m][1] * sc;
                            u32x4 w; w.x = cvt_pk_bf16(v0[0], v0[1]); w.y = cvt_pk_bf16(v0[2], v0[3]); w.z = cvt_pk_bf16(v1[0], v1[1]); w.w = cvt_pk_bf16(v1[2], v1[3]);
                            *(u32x4*)(base + (((((size_t)(b * 8 + h) * 128 + blk) * 4 + s) * 64 + hi * 32 + r) * 8)) = w; } }
            }
        } else {
            const int gc0 = (pn - 12) * 256 + wc * 32 + 8 * fq;
            f32x4 bv[2][2];
#pragma unroll
            for (int bj = 0; bj < 2; ++bj)
#pragma unroll
                for (int n = 0; n < 2; ++n) bv[bj][n] = *(const f32x4*)(bgate + gc0 + bj * HALF + 4 * n);
#pragma unroll
            for (int ai = 0; ai < 2; ++ai)
#pragma unroll
                for (int m = 0; m < 4; ++m) { bf16_t* rowp = gates + (size_t)(row0 + ai * HALF + m * 16) * 2048 + gc0;
#pragma unroll
                    for (int bj = 0; bj < 2; ++bj) { const f32x4 v0 = acc[ai][bj][m][0] + bv[bj][0], v1 = acc[ai][bj][m][1] + bv[bj][1];
                        u32x4 w; w.x = cvt_pk_bf16(sigmoid_f(v0[0]), sigmoid_f(v0[1])); w.y = cvt_pk_bf16(sigmoid_f(v0[2]), sigmoid_f(v0[3]));
                        w.z = cvt_pk_bf16(sigmoid_f(v1[0]), sigmoid_f(v1[1])); w.w = cvt_pk_bf16(sigmoid_f(v1[2]), sigmoid_f(v1[3]));
                        *(u32x4*)(rowp + bj * HALF) = w; } }
        }
    }
};

struct EpiMerge {
    static constexpr bool PERM = true, AFTER_DRAIN = false;
    const bf16_t* gates; float* T; bf16_t* merged;
    __device__ __forceinline__ void operator()(const f32x4 (&acc)[2][2][4][2], const Unit& u, int wr, int wc, int fr, int fq) const {
        const bool ca = u.pm >= 128; const int pm = u.pm & 127, pn = u.pn & 3;
        const int row0 = pm * BM + wr * 64 + fr, col0 = pn * BM + wc * 32 + 8 * fq;
        const bf16_t* gb = gates + (ca ? 1024 : 0) + col0;
#pragma unroll
        for (int ai = 0; ai < 2; ++ai)
#pragma unroll
            for (int m = 0; m < 4; ++m) { const size_t row = (size_t)(row0 + ai * HALF + m * 16);
#pragma unroll
                for (int bj = 0; bj < 2; ++bj) {
                    const u32x4 gw = *(const u32x4*)(gb + row * 2048 + bj * HALF);
                    f32x4 g0, g1;
                    g0[0] = __uint_as_float(gw.x << 16); g0[1] = __uint_as_float(gw.x & 0xffff0000u); g0[2] = __uint_as_float(gw.y << 16); g0[3] = __uint_as_float(gw.y & 0xffff0000u);
                    g1[0] = __uint_as_float(gw.z << 16); g1[1] = __uint_as_float(gw.z & 0xffff0000u); g1[2] = __uint_as_float(gw.w << 16); g1[3] = __uint_as_float(gw.w & 0xffff0000u);
                    f32x4 v0 = acc[ai][bj][m][0] * g0, v1 = acc[ai][bj][m][1] * g1;
                    float* tp = T + row * 1024 + col0 + bj * HALF;
                    if (!ca) { *(f32x4*)tp = v0; *(f32x4*)(tp + 4) = v1; }
                    else { v0 += *(const f32x4*)tp; v1 += *(const f32x4*)(tp + 4);
                        u32x4 w; w.x = cvt_pk_bf16(v0[0], v0[1]); w.y = cvt_pk_bf16(v0[2], v0[3]); w.z = cvt_pk_bf16(v1[0], v1[1]); w.w = cvt_pk_bf16(v1[2], v1[3]);
                        *(u32x4*)(merged + row * 1024 + col0 + bj * HALF) = w; } } }
    }
};

struct EpiRes {
    static constexpr bool PERM = false, AFTER_DRAIN = false;
    const float* base; float* out; float alpha;
    __device__ __forceinline__ void operator()(const f32x4 (&acc)[2][2][4][2], const Unit& u, int wr, int wc, int fr, int fq) const {
        const int row0 = u.pm * BM + wr * 64 + fr, col0 = u.pn * BM + wc * 32 + 4 * fq;
#pragma unroll
        for (int ai = 0; ai < 2; ++ai)
#pragma unroll
            for (int m = 0; m < 4; ++m) { const size_t off = (size_t)(row0 + ai * HALF + m * 16) * 1024 + col0;
#pragma unroll
                for (int bj = 0; bj < 2; ++bj)
#pragma unroll
                    for (int n = 0; n < 2; ++n) { const f32x4 bs = *(const f32x4*)(base + off + bj * HALF + n * 16); *(f32x4*)(out + off + bj * HALF + n * 16) = bs * alpha + acc[ai][bj][m][n]; } }
    }
};

struct EpiRelu2 {
    static constexpr bool PERM = true, AFTER_DRAIN = false;
    bf16_t* O;
    __device__ __forceinline__ void operator()(const f32x4 (&acc)[2][2][4][2], const Unit& u, int wr, int wc, int fr, int fq) const {
        const int row0 = u.pm * BM + wr * 64 + fr, col0 = u.pn * BM + wc * 32 + 8 * fq;
#pragma unroll
        for (int ai = 0; ai < 2; ++ai)
#pragma unroll
            for (int m = 0; m < 4; ++m) { bf16_t* rowp = O + (size_t)(row0 + ai * HALF + m * 16) * DFF + col0;
#pragma unroll
                for (int bj = 0; bj < 2; ++bj) { f32x4 v0 = acc[ai][bj][m][0], v1 = acc[ai][bj][m][1];
#pragma unroll
                    for (int j = 0; j < 4; ++j) { const float a = fmaxf(v0[j], 0.f), b = fmaxf(v1[j], 0.f); v0[j] = a * a; v1[j] = b * b; }
                    u32x4 w; w.x = cvt_pk_bf16(v0[0], v0[1]); w.y = cvt_pk_bf16(v0[2], v0[3]); w.z = cvt_pk_bf16(v1[0], v1[1]); w.w = cvt_pk_bf16(v1[2], v1[3]);
                    *(u32x4*)(rowp + bj * HALF) = w; } }
    }
};

template <class Epi, class Sched, bool ALIGN_EPI = false, bool SP2 = false>
__device__ __forceinline__ void gemm_phase(PG8_LAS unsigned char* lds, const Gemm g, const Sched& S, const Epi& E) {
    const int tid = threadIdx.x, wid = __builtin_amdgcn_readfirstlane(tid >> 6), lane = tid & 63, wr = wid >> 2, wc = wid & 3, fr = lane & 15, fq = lane >> 4;
    const int K = g.K, nt = K / BK;
    unsigned voffA[2], voffB[2];
#pragma unroll
    for (int i = 0; i < 2; ++i) { int R, C; stage_rc(tid * 16 + i * 8192, R, C); const int Rb = Epi::PERM ? ((R & ~31) + perm32(R & 31)) : R;
        voffA[i] = (unsigned)(R * K + C) * 2u; voffB[i] = (unsigned)(Rb * K + C) * 2u; }
    const size_t kstep = (size_t)(BK * 2);
    const size_t hstep = (size_t)HALF * K * 2;
    const size_t tstep = 2 * hstep;
    const unsigned ldsw = (unsigned)wid * 1024u;
    const int aoff = lds_byte(wr * 64 + fr, fq * 8), boff = lds_byte(wc * 32 + fr, fq * 8);
#define PG8_SA(b, h) (((b) * 2 + (h)) * HTB)
#define PG8_SB(b, h) ((4 + (b) * 2 + (h)) * HTB)
#define PG8_STAGE(bufoff, gbase, voff) do { _Pragma("unroll") for (int _i = 0; _i < 2; ++_i) \
        __builtin_amdgcn_global_load_lds((const unsigned*)((const char*)(gbase) + (voff)[_i]), (PG8_LAS unsigned*)(lds + (bufoff) + ldsw + _i * 8192), 16, 0, 0); } while (0)
#define PG8_LDA(dst, b, h) do { _Pragma("unroll") for (int m = 0; m < 4; ++m) _Pragma("unroll") for (int k = 0; k < 2; ++k) dst[m][k] = *(const PG8_LAS bf16x8*)(lds + PG8_SA(b, h) + aoff + m * 2048 + k * 1024); } while (0)
#define PG8_LDB(dst, b, h) do { _Pragma("unroll") for (int n = 0; n < 2; ++n) _Pragma("unroll") for (int k = 0; k < 2; ++k) dst[n][k] = *(const PG8_LAS bf16x8*)(lds + PG8_SB(b, h) + boff + n * 2048 + k * 1024); } while (0)
#define PG8_MMA(ai, bj, At, Bt) do { __builtin_amdgcn_s_setprio(1); _Pragma("unroll") for (int m = 0; m < 4; ++m) _Pragma("unroll") for (int n = 0; n < 2; ++n) _Pragma("unroll") for (int k = 0; k < 2; ++k) \
        acc[ai][bj][m][n] = __builtin_amdgcn_mfma_f32_16x16x32_bf16(Bt[n][k], At[m][k], acc[ai][bj][m][n], 0, 0, 0); __builtin_amdgcn_s_setprio(0); } while (0)
#define PG8_WAIT_V(n) asm volatile("s_waitcnt vmcnt(" #n ")" ::: "memory")
#define PG8_WAIT_L(n) asm volatile("s_waitcnt lgkmcnt(" #n ")" ::: "memory")
#define PG8_BAR __builtin_amdgcn_s_barrier()
#define PG8_SCHED __builtin_amdgcn_sched_barrier(0)
    Unit cur, nxt; int ui = 0;
    if (!S.next(0, cur)) return;
    f32x4 acc[2][2][4][2];
#pragma unroll
    for (int a = 0; a < 2; ++a)
#pragma unroll
        for (int b = 0; b < 2; ++b)
#pragma unroll
            for (int m = 0; m < 4; ++m)
#pragma unroll
                for (int n = 0; n < 2; ++n) acc[a][b][m][n] = (f32x4){0.f, 0.f, 0.f, 0.f};
    bf16x8 At[4][2], B0[2][2], B1[2][2];
    const char* cA = (const char*)g.A + (size_t)cur.pm * tstep; const char* cB = (const char*)g.Bt + (size_t)cur.pn * tstep;
    S.a_ready(cur);
    if constexpr (SP2) {
        PG8_STAGE(PG8_SB(0, 0), cB, voffB); PG8_STAGE(PG8_SB(0, 1), cB + hstep, voffB); PG8_STAGE(PG8_SA(0, 0), cA, voffA); PG8_STAGE(PG8_SA(0, 1), cA + hstep, voffA);
        if (wr == 1) PG8_BAR;
        PG8_WAIT_V(2); PG8_BAR;
        PG8_STAGE(PG8_SB(1, 0), cB + kstep, voffB); PG8_STAGE(PG8_SA(1, 0), cA + kstep, voffA); PG8_STAGE(PG8_SB(1, 1), cB + hstep + kstep, voffB);
        PG8_WAIT_V(6); PG8_BAR;
    } else {
        PG8_STAGE(PG8_SB(0, 0), cB, voffB); PG8_STAGE(PG8_SA(0, 0), cA, voffA); PG8_STAGE(PG8_SB(0, 1), cB + hstep, voffB); PG8_STAGE(PG8_SA(0, 1), cA + hstep, voffA);
        if (wr == 1) PG8_BAR;
        PG8_WAIT_V(4); PG8_BAR;
        PG8_STAGE(PG8_SB(1, 0), cB + kstep, voffB); PG8_STAGE(PG8_SA(1, 0), cA + kstep, voffA); PG8_STAGE(PG8_SB(1, 1), cB + hstep + kstep, voffB);
        PG8_WAIT_V(6); PG8_BAR;
    }
    for (;;) {
        const bool has_next = S.next(ui + 1, nxt);
        const char* nA = has_next ? (const char*)g.A + (size_t)nxt.pm * tstep : cA; const char* nB = has_next ? (const char*)g.Bt + (size_t)nxt.pn * tstep : cB;
        for (int t = 0; t < nt; t += 2) {
            const bool last = (t == nt - 2);
            const char* a1 = cA + (size_t)(t + 1) * kstep;
            const char* a2 = last ? nA : cA + (size_t)(t + 2) * kstep; const char* b2 = last ? nB : cB + (size_t)(t + 2) * kstep;
            const char* a3 = a2 + kstep; const char* b3 = b2 + kstep;
            if (last && has_next) S.a_ready(nxt);
            if constexpr (SP2) {
            PG8_LDB(B0, 0, 0); PG8_LDB(B1, 0, 1); PG8_SCHED; PG8_LDA(At, 0, 0); PG8_STAGE(PG8_SA(1, 1), a1 + hstep, voffA);
            PG8_WAIT_V(8); PG8_WAIT_L(0); PG8_BAR; PG8_MMA(0, 0, At, B0); PG8_MMA(0, 1, At, B1); PG8_BAR; PG8_SCHED;
            PG8_LDA(At, 0, 1); PG8_STAGE(PG8_SB(0, 0), b2, voffB); PG8_STAGE(PG8_SB(0, 1), b2 + hstep, voffB); PG8_STAGE(PG8_SA(0, 0), a2, voffA);
            PG8_WAIT_V(8); PG8_WAIT_L(0); PG8_BAR; PG8_MMA(1, 0, At, B0); PG8_MMA(1, 1, At, B1); PG8_BAR; PG8_SCHED;
            PG8_LDB(B0, 1, 0); PG8_LDB(B1, 1, 1); PG8_SCHED; PG8_LDA(At, 1, 0); PG8_STAGE(PG8_SA(0, 1), a2 + hstep, voffA);
            PG8_WAIT_V(8); PG8_WAIT_L(0); PG8_BAR; PG8_MMA(0, 0, At, B0); PG8_MMA(0, 1, At, B1); PG8_BAR; PG8_SCHED;
            PG8_LDA(At, 1, 1); PG8_STAGE(PG8_SB(1, 0), b3, voffB); PG8_STAGE(PG8_SB(1, 1), b3 + hstep, voffB); PG8_STAGE(PG8_SA(1, 0), a3, voffA);
            PG8_WAIT_V(8); PG8_WAIT_L(0); PG8_BAR; PG8_MMA(1, 0, At, B0); PG8_MMA(1, 1, At, B1); PG8_BAR; PG8_SCHED;
            } else {
            PG8_LDB(B0, 0, 0); PG8_SCHED; PG8_LDA(At, 0, 0); PG8_STAGE(PG8_SA(1, 1), a1 + hstep, voffA);
            PG8_WAIT_L(8); PG8_BAR; PG8_WAIT_L(0); PG8_MMA(0, 0, At, B0); PG8_BAR; PG8_SCHED;
            PG8_LDB(B1, 0, 1); PG8_STAGE(PG8_SB(0, 0), b2, voffB);
            PG8_BAR; PG8_WAIT_L(0); PG8_MMA(0, 1, At, B1); PG8_BAR;
            PG8_LDA(At, 0, 1); PG8_STAGE(PG8_SA(0, 0), a2, voffA);
            PG8_BAR; PG8_WAIT_L(0); PG8_MMA(1, 0, At, B0); PG8_BAR; PG8_SCHED;
            PG8_STAGE(PG8_SB(0, 1), b2 + hstep, voffB);
            PG8_WAIT_V(6); PG8_BAR; PG8_MMA(1, 1, At, B1); PG8_BAR;
            PG8_LDB(B0, 1, 0); PG8_SCHED; PG8_LDA(At, 1, 0); PG8_STAGE(PG8_SA(0, 1), a2 + hstep, voffA);
            PG8_WAIT_L(8); PG8_BAR; PG8_WAIT_L(0); PG8_MMA(0, 0, At, B0); PG8_BAR; PG8_SCHED;
            PG8_LDB(B1, 1, 1); PG8_STAGE(PG8_SB(1, 0), b3, voffB);
            PG8_BAR; PG8_WAIT_L(0); PG8_MMA(0, 1, At, B1); PG8_BAR;
            PG8_LDA(At, 1, 1); PG8_STAGE(PG8_SA(1, 0), a3, voffA);
            PG8_BAR; PG8_WAIT_L(0); PG8_MMA(1, 0, At, B0); PG8_BAR; PG8_SCHED;
            PG8_STAGE(PG8_SB(1, 1), b3 + hstep, voffB);
            PG8_WAIT_V(6); PG8_BAR; PG8_MMA(1, 1, At, B1); PG8_BAR;
            }
        }
        if constexpr (ALIGN_EPI) { if (wr == 0) PG8_BAR; }
        if constexpr (!Epi::AFTER_DRAIN) { E(acc, cur, wr, wc, fr, fq); S.done(cur); }
        if (!has_next) break;
#pragma unroll
        for (int a = 0; a < 2; ++a)
#pragma unroll
            for (int b = 0; b < 2; ++b)
#pragma unroll
                for (int m = 0; m < 4; ++m)
#pragma unroll
                    for (int n = 0; n < 2; ++n) acc[a][b][m][n] = (f32x4){0.f, 0.f, 0.f, 0.f};
        cur = nxt; cA = nA; cB = nB; ++ui;
        if constexpr (ALIGN_EPI) { if (wr == 1) PG8_BAR; }
    }
    PG8_WAIT_V(0);
    if constexpr (!ALIGN_EPI) { if (wr == 0) PG8_BAR; }
    PG8_BAR;
    if constexpr (Epi::AFTER_DRAIN) { E.fused(acc, cur, wr, wc, fr, fq, lds, wid, lane); S.done(cur); }
#undef PG8_SA
#undef PG8_SB
#undef PG8_STAGE
#undef PG8_LDA
#undef PG8_LDB
#undef PG8_MMA
#undef PG8_WAIT_V
#undef PG8_WAIT_L
#undef PG8_BAR
#undef PG8_SCHED
}
}

#define GAS __attribute__((address_space(1)))
#define LAS __attribute__((address_space(3)))
typedef unsigned short bf16;
typedef unsigned v4u __attribute__((ext_vector_type(4)));
typedef unsigned v2u __attribute__((ext_vector_type(2)));
typedef float f32x4 __attribute__((ext_vector_type(4)));
typedef float f32x16 __attribute__((ext_vector_type(16)));
typedef short bf16x8 __attribute__((ext_vector_type(8)));
typedef short s16x4 __attribute__((ext_vector_type(4)));
constexpr int NWAVES = 8;
constexpr float LN_EPS = 1e-5f;
constexpr float DN_ALPHA = 1.189207115002721f;
constexpr int LDS_BYTES = 147456;
#define LDS_WAIT() asm volatile("s_waitcnt lgkmcnt(0)" ::: "memory")

constexpr size_t MiB = 1u << 20;
constexpr size_t WS_W_IN = 2 * MiB, WS_W_SC = 12 * MiB, WS_W_OUT = 14 * MiB, WS_W_MI = 16 * MiB, WS_W_MO = 24 * MiB;
constexpr size_t WS_XB = 32 * MiB;
constexpr size_t WS_QKV = 96 * MiB;
constexpr size_t WS_GATES = 288 * MiB;
constexpr size_t WS_O2 = 416 * MiB;
constexpr size_t WS_T = 96 * MiB;
constexpr size_t WS_MERGED = 224 * MiB;
constexpr size_t WS_H = 96 * MiB;
constexpr size_t WS_END = 480 * MiB;
constexpr size_t WS_CTL = 0, CTL_ZERO_BYTES = 16384;
constexpr int BAR_LDS_OFF = 131072 + 512;

__device__ __forceinline__ float wave_sum(float v) {
#pragma unroll
    for (int o = 1; o < 64; o <<= 1) v += __shfl_xor(v, o);
    return v;
}
__device__ __forceinline__ unsigned pk2(float lo, float hi) { return pg8::cvt_pk_bf16(lo, hi); }

__device__ __forceinline__ void p0_transpose_item(const float* W, int K, int N, bf16* WT, int row_off, LAS float* scr, int item, int lane) {
    const int nblk = N / 32, kb = item / nblk, nb = item % nblk, k0 = 64 * kb, n0 = 32 * nb;
#pragma unroll 8
    for (int i = 0; i < 32; ++i) { const int kk = 2 * i + (lane >> 5); scr[kk * 33 + (lane & 31)] = W[(size_t)(k0 + kk) * N + n0 + (lane & 31)]; }
    LDS_WAIT(); asm volatile("" ::: "memory");
    const int c = lane & 7;
#pragma unroll
    for (int j = 0; j < 4; ++j) { const int n = (lane >> 3) + 8 * j; const LAS float* s = scr + (8 * c) * 33 + n;
        v4u o; o.x = pk2(s[0 * 33], s[1 * 33]); o.y = pk2(s[2 * 33], s[3 * 33]); o.z = pk2(s[4 * 33], s[5 * 33]); o.w = pk2(s[6 * 33], s[7 * 33]);
        *(GAS v4u*)(WT + (size_t)(row_off + n0 + n) * K + k0 + 8 * c) = o; }
    LDS_WAIT(); asm volatile("" ::: "memory");
}

__device__ __forceinline__ void row_to_bf16(const float* xrow, bf16* orow, int lane) {
    const f32x4* xr = (const f32x4*)xrow + lane; v2u* o8 = (v2u*)orow + lane;
#pragma unroll
    for (int j = 0; j < 4; ++j) { const f32x4 v = xr[64 * j]; v2u w; w.x = pk2(v[0], v[1]); w.y = pk2(v[2], v[3]); o8[64 * j] = w; }
}
__device__ __forceinline__ void ln_row(float* row, bf16* brow, const float* g, const float* bta, int lane) {
    f32x4* xr = (f32x4*)row + lane; f32x4 v[4]; float s = 0.f;
#pragma unroll
    for (int j = 0; j < 4; ++j) { v[j] = xr[64 * j]; s += (v[j][0] + v[j][1]) + (v[j][2] + v[j][3]); }
    const float mean = wave_sum(s) * (1.f / 1024.f); float s2 = 0.f;
#pragma unroll
    for (int j = 0; j < 4; ++j) { v[j] = v[j] - mean; s2 += (v[j][0] * v[j][0] + v[j][1] * v[j][1]) + (v[j][2] * v[j][2] + v[j][3] * v[j][3]); }
    const float rstd = 1.f / sqrtf(wave_sum(s2) * (1.f / 1024.f) + LN_EPS);
#pragma unroll
    for (int j = 0; j < 4; ++j) { const f32x4 gg = ((const f32x4*)g)[lane + 64 * j], bb = ((const f32x4*)bta)[lane + 64 * j]; const f32x4 y = v[j] * rstd * gg + bb; xr[64 * j] = y;
        if (brow) { v2u w; w.x = pk2(y[0], y[1]); w.y = pk2(y[2], y[3]); ((v2u*)brow)[lane + 64 * j] = w; } }
}

#define XB_TMO      128
#define XB_XCNT(j)  (256  + 64 * (j))
#define XB_XSUB(j)  (1280 + 64 * (j))
#define XB_XGEN(j)  (2304 + 64 * (j))
#define XB_TOP      3328
#define XB_TOPGEN   3392
#define XCD_BAR_WORDS 3456
#define XB_SPIN_CAP (1u << 18)

__device__ __forceinline__ unsigned xb_ld(unsigned* p)              { return __hip_atomic_load(p, __ATOMIC_RELAXED, __HIP_MEMORY_SCOPE_AGENT); }
__device__ __forceinline__ unsigned xb_add(unsigned* p, unsigned v) { return __hip_atomic_fetch_add(p, v, __ATOMIC_RELAXED, __HIP_MEMORY_SCOPE_AGENT); }
__device__ __forceinline__ unsigned xb_xcc_id() { return (unsigned)__builtin_amdgcn_s_getreg((3 << 11) | 20) & 0xFu; }
#define XB_SPIN(cond, bar) do { unsigned _sp = 0; while (cond) { __builtin_amdgcn_s_sleep(1); \
    if ((++_sp & 255u) == 0u) { if (xb_ld(&(bar)[XB_TMO])) break; if (_sp > XB_SPIN_CAP) { atomicAdd(&(bar)[XB_TMO], 1u); break; } } } } while (0)

struct XcdBarrier {
    unsigned* bar; unsigned x;
    volatile LAS unsigned* st;
};

__device__ __forceinline__ XcdBarrier xcd_barrier_post(unsigned* bar, volatile LAS unsigned* st) {
    XcdBarrier b; b.bar = bar; b.x = xb_xcc_id(); b.st = st;
    if (threadIdx.x == 0) (void)xb_add(&bar[XB_XCNT(b.x)], 1u);
    return b;
}
__device__ __forceinline__ void xcd_barrier_complete(unsigned* bar, unsigned x, unsigned& nloc, unsigned& nx) {
    const unsigned G = gridDim.x * gridDim.y * gridDim.z;
    unsigned sum, cnt, mine, sp = 0u;
    for (;;) {
        sum = 0u; cnt = 0u; mine = 0u;
#pragma unroll
        for (unsigned j = 0; j < 16; ++j) { const unsigned c = xb_ld(&bar[XB_XCNT(j)]); sum += c; cnt += (c > 0u) ? 1u : 0u; mine = (j == x) ? c : mine; }
        if (sum == G) break;
        __builtin_amdgcn_s_sleep(1);
        if ((++sp & 255u) == 0u) { if (xb_ld(&bar[XB_TMO])) break; if (sp > XB_SPIN_CAP) { atomicAdd(&bar[XB_TMO], 1u); break; } }
    }
    nloc = mine > 0u ? mine : 1u; nx = cnt > 0u ? cnt : 1u;
}

__device__ __forceinline__ void xcd_barrier(const XcdBarrier& b) {
    asm volatile("s_waitcnt vmcnt(0)" ::: "memory");
    __syncthreads();
    if (threadIdx.x == 0) {
        unsigned* bar = b.bar;
        __builtin_amdgcn_s_waitcnt(0);
        unsigned nloc = b.st[0], nx = b.st[1];
        if (nloc == 0u) { xcd_barrier_complete(bar, b.x, nloc, nx); b.st[0] = nloc; b.st[1] = nx; }
        const unsigned old = xb_add(&bar[XB_XSUB(b.x)], 1u);
        const unsigned gen = old / nloc;
        if (old + 1u == (gen + 1u) * nloc) {
            __builtin_amdgcn_fence(__ATOMIC_RELEASE, "agent");
            asm volatile("s_waitcnt vmcnt(0)" ::: "memory");
            const unsigned og = xb_add(&bar[XB_TOP], 1u);
            const unsigned tg = og / nx;
            if (og + 1u == (tg + 1u) * nx) xb_add(&bar[XB_TOPGEN], 1u);
            else XB_SPIN(xb_ld(&bar[XB_TOPGEN]) == tg, bar);
            __builtin_amdgcn_fence(__ATOMIC_ACQUIRE, "agent");
            xb_add(&bar[XB_XGEN(b.x)], 1u);
            asm volatile("s_waitcnt vmcnt(0)" ::: "memory");
        } else {
            XB_SPIN(xb_ld(&bar[XB_XGEN(b.x)]) == gen, bar);
            __builtin_amdgcn_fence(__ATOMIC_ACQUIRE, "agent");
            asm volatile("s_waitcnt vmcnt(0)" ::: "memory");
        }
    }
    __syncthreads();
}

#define MFMA32(a, b, c) __builtin_amdgcn_mfma_f32_32x32x16_bf16((a), (b), (c), 0, 0, 0)
__device__ __forceinline__ int crow(int reg, int h) { return (reg & 3) + 8 * (reg >> 2) + 4 * h; }
__device__ __forceinline__ void load_frag4(bf16x8 (&f)[4], const bf16* p  , int lane) {
    const bf16x8* q = (const bf16x8*)p + lane;
#pragma unroll
    for (int s = 0; s < 4; ++s) f[s] = q[64 * s];
}
__device__ __forceinline__ void load_vt(bf16x8 (&v)[2][2], const bf16* p  , int lane) {
    const bf16x8* q = (const bf16x8*)p + lane;
#pragma unroll
    for (int db = 0; db < 2; ++db)
#pragma unroll
        for (int s = 0; s < 2; ++s) v[db][s] = q[64 * (db * 2 + s)];
}
__device__ __forceinline__ bf16x8 pack8(const float (&p)[16], int s) {
    v4u w; w.x = pk2(p[8 * s], p[8 * s + 1]); w.y = pk2(p[8 * s + 2], p[8 * s + 3]); w.z = pk2(p[8 * s + 4], p[8 * s + 5]); w.w = pk2(p[8 * s + 6], p[8 * s + 7]);
    return __builtin_bit_cast(bf16x8, w);
}
__device__ __forceinline__ void store_o(bf16* orow  , const f32x16& o0, const f32x16& o1, float sc, int hi) {
#pragma unroll
    for (int g = 0; g < 4; ++g) { v2u w0, w1;
        w0.x = pk2(o0[4 * g] * sc, o0[4 * g + 1] * sc); w0.y = pk2(o0[4 * g + 2] * sc, o0[4 * g + 3] * sc);
        w1.x = pk2(o1[4 * g] * sc, o1[4 * g + 1] * sc); w1.y = pk2(o1[4 * g + 2] * sc, o1[4 * g + 3] * sc);
        *(v2u*)(orow + 8 * g + 4 * hi) = w0; *(v2u*)(orow + 32 + 8 * g + 4 * hi) = w1; }
}

__device__ __forceinline__ void sb_unit(const bf16* Q, const bf16* K, const bf16* VT, bf16* O, int bh, int qb, int lane) {
    const int r = lane & 31, hi = lane >> 5, b = bh >> 3, h = bh & 7;
    const size_t rowbase = (size_t)b * SEQL;
    const bf16* Kh = K + (size_t)bh * 128 * 2048;
    const bf16* VTh = VT + (size_t)bh * 128 * 2048;
    bf16x8 qf[4], kf[4];
    load_frag4(qf, Q + ((size_t)bh * 128 + qb) * 2048, lane);
    load_frag4(kf, Kh + (size_t)qb * 2048, lane);
    f32x16 o0, o1;
#pragma unroll
    for (int i = 0; i < 16; ++i) { o0[i] = 0.f; o1[i] = 0.f; }
    float R = 0.f;
    for (int kb = qb; kb >= 0; --kb) {
        bf16x8 vf[2][2], kn[4];
        load_vt(vf, VTh + (size_t)kb * 2048, lane);
        load_frag4(kn, Kh + (size_t)(kb > 0 ? kb - 1 : 0) * 2048, lane);
        f32x16 z;
#pragma unroll
        for (int i = 0; i < 16; ++i) z[i] = 0.f;
#pragma unroll
        for (int s = 0; s < 4; ++s) z = MFMA32(kf[s], qf[s], z);
        const bool diag = (kb == qb);
        float lk[16], ls[16], G[4];
#pragma unroll
        for (int g = 0; g < 4; ++g) G[g] = 0.f;
#pragma unroll
        for (int i = 0; i < 16; ++i) {
            const float zi = z[i];
            const bool valid = !diag || (crow(i, hi) < r);
            const float sp = fmaxf(zi, 0.f) + __logf(1.0f + __expf(-fabsf(zi)));
            lk[i] = valid ? -sp : 0.f;
            ls[i] = valid ? (zi - sp) : -INFINITY;
            G[i >> 2] += lk[i];
        }
        float Hh[4], A[4];
#pragma unroll
        for (int g = 0; g < 4; ++g) Hh[g] = __shfl_xor(G[g], 32);
        float run = 0.f;
#pragma unroll
        for (int g = 3; g >= 0; --g) { A[g] = run + (hi ? 0.f : Hh[g]); run += G[g] + Hh[g]; }
        float p[16];
#pragma unroll
        for (int g = 0; g < 4; ++g) { float e = R + A[g];
#pragma unroll
            for (int j = 3; j >= 0; --j) { p[4 * g + j] = __expf(ls[4 * g + j] + e); e += lk[4 * g + j]; } }
        R += run;
        const bf16x8 p0 = pack8(p, 0), p1 = pack8(p, 1);
        o0 = MFMA32(vf[0][0], p0, o0); o0 = MFMA32(vf[0][1], p1, o0);
        o1 = MFMA32(vf[1][0], p0, o1); o1 = MFMA32(vf[1][1], p1, o1);
#pragma unroll
        for (int s = 0; s < 4; ++s) kf[s] = kn[s];
        if (__all(R < -106.0f)) break;
    }
    store_o(O + (rowbase + qb * 32 + r) * 512 + h * 64, o0, o1, 1.0f, hi);
}

__device__ __forceinline__ void ca_unit(const bf16* Q, const bf16* K, const bf16* VT, bf16* O, const LAS float* tab, int bh, int c, int hf, int lane) {
    const int r = lane & 31, hi = lane >> 5, b = bh >> 3, h = bh & 7;
    const size_t rowbase = (size_t)b * SEQL;
    const bf16* Kh = K + (size_t)bh * 128 * 2048;
    const bf16* VTh = VT + (size_t)bh * 128 * 2048;
    const int t0 = c * 64 + hf * 32;
    const int kb0 = (c > 8 ? c - 8 : 0) * 2, kb1 = (c + 1) * 2;
    bf16x8 qf[4], kf[4];
    load_frag4(qf, Q + ((size_t)bh * 128 + (t0 >> 5)) * 2048, lane);
    load_frag4(kf, Kh + (size_t)kb0 * 2048, lane);
    f32x16 o0, o1;
#pragma unroll
    for (int i = 0; i < 16; ++i) { o0[i] = 0.f; o1[i] = 0.f; }
    float mrun = -INFINITY, l = 0.f;
    const float bias_far = tab[512];
    for (int kb = kb0; kb < kb1; ++kb) {
        bf16x8 vf[2][2], kn[4];
        load_vt(vf, VTh + (size_t)kb * 2048, lane);
        load_frag4(kn, Kh + (size_t)(kb + 1 < kb1 ? kb + 1 : kb) * 2048, lane);
        f32x16 z;
#pragma unroll
        for (int i = 0; i < 16; ++i) z[i] = 0.f;
#pragma unroll
        for (int s = 0; s < 4; ++s) z = MFMA32(kf[s], qf[s], z);
        const int k0 = kb * 32;
        float zz[16];
        if (t0 - (k0 + 31) >= 256) {
#pragma unroll
            for (int i = 0; i < 16; ++i) zz[i] = z[i] + bias_far;
        } else {
            const int d0 = t0 + r - k0 + 256;
#pragma unroll
            for (int i = 0; i < 16; ++i) { int idx = d0 - crow(i, hi); idx = idx < 0 ? 0 : (idx > 512 ? 512 : idx); zz[i] = z[i] + tab[idx]; }
        }
        float mx = zz[0];
#pragma unroll
        for (int i = 1; i < 16; ++i) mx = fmaxf(mx, zz[i]);
        mx = fmaxf(mx, __shfl_xor(mx, 32));
        const float mnew = fmaxf(mrun, mx);
        const float alpha = __expf(mrun - mnew);
        float p[16]; float ps = 0.f;
#pragma unroll
        for (int i = 0; i < 16; ++i) { p[i] = __expf(zz[i] - mnew); ps += p[i]; }
        l = l * alpha + ps; mrun = mnew;
#pragma unroll
        for (int i = 0; i < 16; ++i) { o0[i] *= alpha; o1[i] *= alpha; }
        const bf16x8 p0 = pack8(p, 0), p1 = pack8(p, 1);
        o0 = MFMA32(vf[0][0], p0, o0); o0 = MFMA32(vf[0][1], p1, o0);
        o1 = MFMA32(vf[1][0], p0, o1); o1 = MFMA32(vf[1][1], p1, o1);
#pragma unroll
        for (int s = 0; s < 4; ++s) kf[s] = kn[s];
    }
    l += __shfl_xor(l, 32);
    store_o(O + (rowbase + t0 + r) * 512 + h * 64, o0, o1, 1.0f / l, hi);
}

struct Args { const float* x; const float* w_in; const float* b_gate; const float* w_sb; const float* w_ca; const float* rel_bias; const float* w_out; const float* ln1_g; const float* ln1_b;
              const float* w_mi; const float* w_mo; const float* ln2_g; const float* ln2_b; float* out; unsigned char* ws; };

__global__ void __launch_bounds__(NWAVES * 64, 2) mk_fwd(Args a) {
    extern __shared__ __attribute__((aligned(16))) unsigned char lds_raw[];
    LAS unsigned char* lds = (LAS unsigned char*)lds_raw;
    cg::grid_group grid = cg::this_grid();
    const int tid = threadIdx.x, lane = tid & 63, wave = __builtin_amdgcn_readfirstlane(tid >> 6);
    const int G = gridDim.x, bx = blockIdx.x;
    const int vcu = (G % 8 == 0) ? (bx % 8) * (G / 8) + bx / 8 : bx;
    const int gw = vcu * NWAVES + wave, NGW = G * NWAVES;
    unsigned char* ws = a.ws;
    bf16* W_IN = (bf16*)(ws + WS_W_IN); bf16* W_SC = (bf16*)(ws + WS_W_SC); bf16* W_OUT = (bf16*)(ws + WS_W_OUT); bf16* W_MI = (bf16*)(ws + WS_W_MI); bf16* W_MO = (bf16*)(ws + WS_W_MO);
    bf16* XB = (bf16*)(ws + WS_XB); bf16* QKV = (bf16*)(ws + WS_QKV); bf16* GATES = (bf16*)(ws + WS_GATES); bf16* O2 = (bf16*)(ws + WS_O2);
    float* T = (float*)(ws + WS_T); bf16* MERGED = (bf16*)(ws + WS_MERGED); bf16* HB = (bf16*)(ws + WS_H);
    constexpr size_t QSZ = (size_t)MTOK * 512;
    volatile LAS unsigned* bst = (volatile LAS unsigned*)(lds + BAR_LDS_OFF);
    if (tid < 4) bst[tid] = 0u;
    __syncthreads();
    const XcdBarrier bar = xcd_barrier_post((unsigned*)(ws + WS_CTL), bst);

    {
        LAS float* scr = (LAS float*)(lds + wave * 16384);
        constexpr int I_IN = (DMODEL / 64) * (NINC / 32), I_SB = (WIDTH / 64) * (DMODEL / 32), I_OUT = (DMODEL / 64) * (DMODEL / 32), I_MI = (DMODEL / 64) * (DFF / 32), I_MO = (DFF / 64) * (DMODEL / 32);
        constexpr int NITEMS = I_IN + 2 * I_SB + I_OUT + I_MI + I_MO;
        for (int it = gw; it < NITEMS; it += NGW) {
            int q = it;
            if (q < I_IN) { p0_transpose_item(a.w_in, DMODEL, NINC, W_IN, 0, scr, q, lane); continue; } q -= I_IN;
            if (q < I_SB) { p0_transpose_item(a.w_sb, WIDTH, DMODEL, W_SC, 0, scr, q, lane); continue; } q -= I_SB;
            if (q < I_SB) { p0_transpose_item(a.w_ca, WIDTH, DMODEL, W_SC, DMODEL, scr, q, lane); continue; } q -= I_SB;
            if (q < I_OUT) { p0_transpose_item(a.w_out, DMODEL, DMODEL, W_OUT, 0, scr, q, lane); continue; } q -= I_OUT;
            if (q < I_MI) { p0_transpose_item(a.w_mi, DMODEL, DFF, W_MI, 0, scr, q, lane); continue; } q -= I_MI;
            p0_transpose_item(a.w_mo, DFF, DMODEL, W_MO, 0, scr, q, lane);
        }
        for (int m = gw; m < MTOK; m += NGW) row_to_bf16(a.x + (size_t)m * DMODEL, XB + (size_t)m * DMODEL, lane);
    }
    grid.sync();

    {
        pg8::Gemm g{XB, W_IN, MTOK, NINC, DMODEL}; pg8::StaticOrder S; S.init(MTOK, NINC, G, bx);
        pg8::EpiIn E{QKV, GATES, a.b_gate};
        pg8::gemm_phase<pg8::EpiIn, pg8::StaticOrder, true, true>(lds, g, S, E);
    }
    xcd_barrier(bar);

    {
        LAS float* tab = (LAS float*)lds;
        for (int i = tid; i < NHEADS * 513; i += NWAVES * 64) tab[i] = a.rel_bias[i];
        __syncthreads();
        for (int u = gw; u < 16384; u += NGW) {
            if (u < 8192) { const int bh = u >> 7, qb = u & 127; sb_unit(QKV, QKV + QSZ, QKV + 2 * QSZ, O2, bh, qb, lane); }
            else { const int v = u - 8192, bh = v >> 7, c = (v & 127) >> 1, hf = v & 1; ca_unit(QKV + 3 * QSZ, QKV + 4 * QSZ, QKV + 5 * QSZ, O2 + QSZ, tab + (bh & 7) * 513, bh, c, hf, lane); }
        }
        __syncthreads();
    }
    xcd_barrier(bar);

    {
        pg8::Gemm g{O2, W_SC, 2 * MTOK, 2 * DMODEL, WIDTH}; pg8::MergeOrder S; S.so.init(MTOK, DMODEL, G, bx);
        pg8::EpiMerge E{GATES, T, MERGED};
        pg8::gemm_phase<pg8::EpiMerge, pg8::MergeOrder, true, true>(lds, g, S, E);
    }
    xcd_barrier(bar);

    {
        pg8::Gemm g{MERGED, W_OUT, MTOK, DMODEL, DMODEL}; pg8::StaticOrder S; S.init(MTOK, DMODEL, G, bx);
        pg8::EpiRes E{a.x, a.out, DN_ALPHA};
        pg8::gemm_phase<pg8::EpiRes, pg8::StaticOrder, true, true>(lds, g, S, E);
    }
    xcd_barrier(bar);

    for (int m = gw; m < MTOK; m += NGW) ln_row(a.out + (size_t)m * DMODEL, XB + (size_t)m * DMODEL, a.ln1_g, a.ln1_b, lane);
    xcd_barrier(bar);

    {
        pg8::Gemm g{XB, W_MI, MTOK, DFF, DMODEL}; pg8::StaticOrder S; S.init(MTOK, DFF, G, bx);
        pg8::EpiRelu2 E{HB};
        pg8::gemm_phase<pg8::EpiRelu2, pg8::StaticOrder, true, true>(lds, g, S, E);
    }
    xcd_barrier(bar);

    {
        pg8::Gemm g{HB, W_MO, MTOK, DMODEL, DFF}; pg8::StaticOrder S; S.init(MTOK, DMODEL, G, bx);
        pg8::EpiRes E{a.out, a.out, DN_ALPHA};
        pg8::gemm_phase<pg8::EpiRes, pg8::StaticOrder, true, true>(lds, g, S, E);
    }
    xcd_barrier(bar);

    for (int m = gw; m < MTOK; m += NGW) ln_row(a.out + (size_t)m * DMODEL, nullptr, a.ln2_g, a.ln2_b, lane);
}

extern "C" void kernel_launch(void* const* d_in, const int* in_sizes, int n_in, void* d_out, int out_size, void* d_ws, size_t ws_size, hipStream_t stream) {
    static int grid = 0;
    if (grid == 0) {
        if (n_in != 13 || in_sizes[0] != MTOK * DMODEL || out_size != MTOK * DMODEL || ws_size < WS_END) { fprintf(stderr, "kernel_launch: unexpected shapes (n_in %d, in0 %d, out %d, ws %zu); nothing launched\n", n_in, n_in > 0 ? in_sizes[0] : -1, out_size, ws_size); grid = -1; return; }
        int dev = 0, cus = 0, per_cu = 0;
        if (hipGetDevice(&dev) != hipSuccess || hipDeviceGetAttribute(&cus, hipDeviceAttributeMultiprocessorCount, dev) != hipSuccess) { fprintf(stderr, "kernel_launch: device query failed\n"); grid = -1; return; }
        if (hipFuncSetAttribute((const void*)mk_fwd, hipFuncAttributeMaxDynamicSharedMemorySize, LDS_BYTES) != hipSuccess) { fprintf(stderr, "kernel_launch: hipFuncSetAttribute failed\n"); grid = -1; return; }
        if (hipOccupancyMaxActiveBlocksPerMultiprocessor(&per_cu, (const void*)mk_fwd, NWAVES * 64, LDS_BYTES) != hipSuccess || per_cu < 1) { fprintf(stderr, "kernel_launch: occupancy query says %d blocks per CU\n", per_cu); per_cu = 1; }
        (void)hipGetLastError();
        grid = cus * 1;
    }
    if (grid < 0) return;
    if (hipMemsetAsync((char*)d_ws + WS_CTL, 0, CTL_ZERO_BYTES, stream) != hipSuccess) { fprintf(stderr, "kernel_launch: memset failed\n"); return; }
    Args a{};
    a.x = (const float*)d_in[0]; a.w_in = (const float*)d_in[1]; a.b_gate = (const float*)d_in[2]; a.w_sb = (const float*)d_in[3]; a.w_ca = (const float*)d_in[4]; a.rel_bias = (const float*)d_in[5];
    a.w_out = (const float*)d_in[6]; a.ln1_g = (const float*)d_in[7]; a.ln1_b = (const float*)d_in[8]; a.w_mi = (const float*)d_in[9]; a.w_mo = (const float*)d_in[10]; a.ln2_g = (const float*)d_in[11]; a.ln2_b = (const float*)d_in[12];
    a.out = (float*)d_out; a.ws = (unsigned char*)d_ws;
    void* args[] = {&a};
    const hipError_t e = hipLaunchCooperativeKernel((const void*)mk_fwd, dim3(grid), dim3(NWAVES * 64), args, LDS_BYTES, stream);
    if (e != hipSuccess) fprintf(stderr, "kernel_launch: cooperative launch failed: %s (grid %d)\n", hipGetErrorString(e), grid);
}
```

```cpp
#include <hip/hip_runtime.h>
#include <hip/hip_cooperative_groups.h>
#include <cstdio>
#include <cstdint>
namespace cg = cooperative_groups;
constexpr int MTOK = 32768, DMODEL = 1024, SEQL = 4096, NBATCH = 8, NHEADS = 8, WIDTH = 512, DFF = 4096, NINC = 5120;
namespace pg8 {
#define PG8_LAS __attribute__((address_space(3)))
typedef unsigned short bf16_t;
typedef short bf16x8 __attribute__((ext_vector_type(8)));
typedef float f32x4 __attribute__((ext_vector_type(4)));
typedef unsigned u32x4 __attribute__((ext_vector_type(4)));
constexpr int BM = 256, BK = 64, HALF = 128, HTB = HALF * BK * 2  , STAGE_BYTES = 8 * HTB, NXCD = 8, WGM = 8;

__host__ __device__ __forceinline__ int lds_byte(int r, int c) { const int st = (r >> 4) * 2 + (c >> 5), rr = r & 15, cc = c & 31, ob = rr * 64 + cc * 2; return st * 1024 + (ob ^ (((ob >> 9) & 1) << 5)); }
__host__ __device__ __forceinline__ void stage_rc(int b, int& R, int& C) { const int st = b / 1024, sb = b % 1024, swz = sb ^ (((sb >> 9) & 1) << 5); R = (st >> 1) * 16 + swz / 64; C = (st & 1) * 32 + (swz % 64) / 2; }
__host__ __device__ __forceinline__ int perm32(int rho) { const int n = rho >> 4, i = rho & 15; return 8 * (i >> 2) + 4 * n + (i & 3); }

struct Unit { int pm, pn; };
struct Gemm { const bf16_t* A; const bf16_t* Bt; int M, N, K; };

struct StaticOrder {
    int nM, nN, nwg, G, c;
    __host__ __device__ void init(int M, int N, int G_, int c_) { nM = M / BM; nN = N / BM; nwg = nM * nN; G = G_; c = c_; }
    __host__ __device__ bool next(int i, Unit& u) const {
        const long L = (long)i * G + c; if (L >= nwg) return false;
        int wgid = (int)L; { const int q = nwg / NXCD, r = nwg % NXCD, xcd = wgid % NXCD, off = wgid / NXCD; wgid = (xcd < r ? xcd * (q + 1) : r * (q + 1) + (xcd - r) * q) + off; }
        const int nig = WGM * nN, gid = wgid / nig, fm = gid * WGM, gsz = (nM - fm) < WGM ? (nM - fm) : WGM;
        u.pm = fm + ((wgid % nig) % gsz); u.pn = (wgid % nig) / gsz; return true;
    }
    __device__ __forceinline__ void a_ready(const Unit&) const {}
    __device__ __forceinline__ void done(const Unit&) const {}
};
typedef float f32x2 __attribute__((ext_vector_type(2)));
typedef __bf16 bf16x2_t __attribute__((ext_vector_type(2)));
__device__ __forceinline__ unsigned cvt_pk_bf16(float lo, float hi) { f32x2 v = {lo, hi}; bf16x2_t b = __builtin_convertvector(v, bf16x2_t); return __builtin_bit_cast(unsigned, b); }
__device__ __forceinline__ float sigmoid_f(float v) { return __builtin_amdgcn_rcpf(1.0f + __expf(-v)); }

struct MergeOrder {
    StaticOrder so;
    __host__ __device__ bool next(int i, Unit& u) const { Unit b; if (!so.next(i >> 1, b)) return false; if (i & 1) { u.pm = b.pm + 128; u.pn = b.pn + 4; } else { u = b; } return true; }
    __device__ __forceinline__ void a_ready(const Unit&) const {}
    __device__ __forceinline__ void done(const Unit&) const {}
};

struct EpiIn {
    static constexpr bool PERM = true, AFTER_DRAIN = false;
    bf16_t* qkv;
    bf16_t* gates;
    const float* bgate;
    __device__ __forceinline__ void operator()(const f32x4 (&acc)[2][2][4][2], const Unit& u, int wr, int wc, int fr, int fq) const {
        const int pn = u.pn; const int row0 = u.pm * BM + wr * 64 + fr;
        if (pn < 12) {
            const int t = pn >> 1; bf16_t* base = qkv + (size_t)t * ((size_t)MTOK * 512);
            const int colt = (pn & 1) * 256 + wc * 32 + 8 * fq;
            if (t == 2 || t == 5) {
#pragma unroll
                for (int ai = 0; ai < 2; ++ai)
#pragma unroll
                    for (int m = 0; m < 4; ++m) { const int row = row0 + ai * HALF + m * 16; const int b = row >> 12, tt = row & 4095;
                        const int kb = tt >> 5, s = (tt >> 4) & 1, k16 = tt & 15, hi = (k16 >> 2) & 1, j = ((k16 >> 3) << 2) | (k16 & 3);
#pragma unroll
                        for (int bj = 0; bj < 2; ++bj) { const int col = colt + bj * HALF, h = col >> 6, d0 = col & 63, db = d0 >> 5, r0 = d0 & 31;
                            bf16_t* pp = base + ((((((size_t)(b * 8 + h) * 128 + kb) * 2 + db) * 2 + s) * 64 + hi * 32 + r0) * 8 + j);
#pragma unroll
                            for (int n = 0; n < 2; ++n) { const f32x4 v = acc[ai][bj][m][n]; const unsigned w0 = cvt_pk_bf16(v[0], v[1]), w1 = cvt_pk_bf16(v[2], v[3]);
                                pp[(4 * n) * 8] = (bf16_t)(w0 & 0xffffu); pp[(4 * n + 1) * 8] = (bf16_t)(w0 >> 16); pp[(4 * n + 2) * 8] = (bf16_t)(w1 & 0xffffu); pp[(4 * n + 3) * 8] = (bf16_t)(w1 >> 16); } } }
            } else {
                const float sc = (t == 0 || t == 3) ? 0.125f : 1.0f;
#pragma unroll
                for (int ai = 0; ai < 2; ++ai)
#pragma unroll
                    for (int m = 0; m < 4; ++m) { const int row = row0 + ai * HALF + m * 16; const int b = row >> 12, tt = row & 4095, blk = tt >> 5, r = tt & 31;
#pragma unroll
                        for (int bj = 0; bj < 2; ++bj) { const int col = colt + bj * HALF, h = col >> 6, d0 = col & 63, s = d0 >> 4, hi = (d0 >> 3) & 1;
                            const f32x4 v0 = acc[ai][bj][m][0] * sc, v1 = acc[ai][bj][m][1] * sc;
                            u32x4 w; w.x = cvt_pk_bf16(v0[0], v0[1]); w.y = cvt_pk_bf16(v0[2], v0[3]); w.z = cvt_pk_bf16(v1[0], v1[1]); w.w = cvt_pk_bf16(v1[2], v1[3]);
                            *(u32x4*)(base + (((((size_t)(b * 8 + h) * 128 + blk) * 4 + s) * 64 + hi * 32 + r) * 8)) = w; } }
            }
        } else {
            const int gc0 = (pn - 12) * 256 + wc * 32 + 8 * fq;
            f32x4 bv[2][2];
#pragma unroll
            for (int bj = 0; bj < 2; ++bj)
#pragma unroll
                for (int n = 0; n < 2; ++n) bv[bj][n] = *(const f32x4*)(bgate + gc0 + bj * HALF + 4 * n);
#pragma unroll
            for (int ai = 0; ai < 2; ++ai)
#pragma unroll
                for (int m = 0; m < 4; ++m) { bf16_t* rowp = gates + (size_t)(row0 + ai * HALF + m * 16) * 2048 + gc0;
#pragma unroll
                    for (int bj = 0; bj < 2; ++bj) { const f32x4 v0 = acc[ai][bj][m][0] + bv[bj][0], v1 = acc[ai][bj][m][1] + bv[bj][1];
                        u32x4 w; w.x = cvt_pk_bf16(sigmoid_f(v0[0]), sigmoid_f(v0[1])); w.y = cvt_pk_bf16(sigmoid_f(v0[2]), sigmoid_f(v0[3]));
                        w.z = cvt_pk_bf16(sigmoid_f(v1[0]), sigmoid_f(v1[1])); w.w = cvt_pk_bf16(sigmoid_f(v1[2]), sigmoid_f(v1[3]));
                        *(u32x4*)(rowp + bj * HALF) = w; } }
        }
    }
};

struct EpiMerge {
    static constexpr bool PERM = true, AFTER_DRAIN = false;
    const bf16_t* gates; float* T; bf16_t* merged;
    __device__ __forceinline__ void operator()(const f32x4 (&acc)[2][2][4][2], const Unit& u, int wr, int wc, int fr, int fq) const {
        const bool ca = u.pm >= 128; const int pm = u.pm & 127, pn = u.pn & 3;
        const int row0 = pm * BM + wr * 64 + fr, col0 = pn * BM + wc * 32 + 8 * fq;
        const bf16_t* gb = gates + (ca ? 1024 : 0) + col0;
#pragma unroll
        for (int ai = 0; ai < 2; ++ai)
#pragma unroll
            for (int m = 0; m < 4; ++m) { const size_t row = (size_t)(row0 + ai * HALF + m * 16);
#pragma unroll
                for (int bj = 0; bj < 2; ++bj) {
                    const u32x4 gw = *(const u32x4*)(gb + row * 2048 + bj * HALF);
                    f32x4 g0, g1;
                    g0[0] = __uint_as_float(gw.x << 16); g0[1] = __uint_as_float(gw.x & 0xffff0000u); g0[2] = __uint_as_float(gw.y << 16); g0[3] = __uint_as_float(gw.y & 0xffff0000u);
                    g1[0] = __uint_as_float(gw.z << 16); g1[1] = __uint_as_float(gw.z & 0xffff0000u); g1[2] = __uint_as_float(gw.w << 16); g1[3] = __uint_as_float(gw.w & 0xffff0000u);
                    f32x4 v0 = acc[ai][bj][m][0] * g0, v1 = acc[ai][bj][m][1] * g1;
                    float* tp = T + row * 1024 + col0 + bj * HALF;
                    if (!ca) { *(f32x4*)tp = v0; *(f32x4*)(tp + 4) = v1; }
                    else { v0 += *(const f32x4*)tp; v1 += *(const f32x4*)(tp + 4);
                        u32x4 w; w.x = cvt_pk_bf16(v0[0], v0[1]); w.y = cvt_pk_bf16(v0[2], v0[3]); w.z = cvt_pk_bf16(v1[0], v1[1]); w.w = cvt_pk_bf16(v1[2], v1[3]);
                        *(u32x4*)(merged + row * 1024 + col0 + bj * HALF) = w; } } }
    }
};

struct EpiRes {
    static constexpr bool PERM = false, AFTER_DRAIN = false;
    const float* base; float* out; float alpha;
    __device__ __forceinline__ void operator()(const f32x4 (&acc)[2][2][4][2], const Unit& u, int wr, int wc, int fr, int fq) const {
        const int row0 = u.pm * BM + wr * 64 + fr, col0 = u.pn * BM + wc * 32 + 4 * fq;
#pragma unroll
        for (int ai = 0; ai < 2; ++ai)
#pragma unroll
            for (int m = 0; m < 4; ++m) { const size_t off = (size_t)(row0 + ai * HALF + m * 16) * 1024 + col0;
#pragma unroll
                for (int bj = 0; bj < 2; ++bj)
#pragma unroll
                    for (int n = 0; n < 2; ++n) { const f32x4 bs = *(const f32x4*)(base + off + bj * HALF + n * 16); *(f32x4*)(out + off + bj * HALF + n * 16) = bs * alpha + acc[ai][bj][m][n]; } }
    }
};

struct EpiRelu2 {
    static constexpr bool PERM = true, AFTER_DRAIN = false;
    bf16_t* O;
    __device__ __forceinline__ void operator()(const f32x4 (&acc)[2][2][4][2], const Unit& u, int wr, int wc, int fr, int fq) const {
        const int row0 = u.pm * BM + wr * 64 + fr, col0 = u.pn * BM + wc * 32 + 8 * fq;
#pragma unroll
        for (int ai = 0; ai < 2; ++ai)
#pragma unroll
            for (int m = 0; m < 4; ++m) { bf16_t* rowp = O + (size_t)(row0 + ai * HALF + m * 16) * DFF + col0;
#pragma unroll
                for (int bj = 0; bj < 2; ++bj) { f32x4 v0 = acc[ai][bj][m][0], v1 = acc[ai][bj][m][1];
#pragma unroll
                    for (int j = 0; j < 4; ++j) { const float a = fmaxf(v0[j], 0.f), b = fmaxf(v1[j], 0.f); v0[j] = a * a; v1[j] = b * b; }
                    u32x4 w; w.x = cvt_pk_bf16(v0[0], v0[1]); w.y = cvt_pk_bf16(v0[2], v0[3]); w.z = cvt_pk_bf16(v1[0], v1[1]); w.w = cvt_pk_bf16(v1[2], v1[3]);
                    *(u32x4*)(rowp + bj * HALF) = w; } }
    }
};

template <class Epi, class Sched, bool ALIGN_EPI = false, bool SP2 = false>
__device__ __forceinline__ void gemm_phase(PG8_LAS unsigned char* lds, const Gemm g, const Sched& S, const Epi& E) {
    const int tid = threadIdx.x, wid = __builtin_amdgcn_readfirstlane(tid >> 6), lane = tid & 63, wr = wid >> 2, wc = wid & 3, fr = lane & 15, fq = lane >> 4;
    const int K = g.K, nt = K / BK;
    unsigned voffA[2], voffB[2];
#pragma unroll
    for (int i = 0; i < 2; ++i) { int R, C; stage_rc(tid * 16 + i * 8192, R, C); const int Rb = Epi::PERM ? ((R & ~31) + perm32(R & 31)) : R;
        voffA[i] = (unsigned)(R * K + C) * 2u; voffB[i] = (unsigned)(Rb * K + C) * 2u; }
    const size_t kstep = (size_t)(BK * 2);
    const size_t hstep = (size_t)HALF * K * 2;
    const size_t tstep = 2 * hstep;
    const unsigned ldsw = (unsigned)wid * 1024u;
    const int aoff = lds_byte(wr * 64 + fr, fq * 8), boff = lds_byte(wc * 32 + fr, fq * 8);
#define PG8_SA(b, h) (((b) * 2 + (h)) * HTB)
#define PG8_SB(b, h) ((4 + (b) * 2 + (h)) * HTB)
#define PG8_STAGE(bufoff, gbase, voff) do { _Pragma("unroll") for (int _i = 0; _i < 2; ++_i) \
        __builtin_amdgcn_global_load_lds((const unsigned*)((const char*)(gbase) + (voff)[_i]), (PG8_LAS unsigned*)(lds + (bufoff) + ldsw + _i * 8192), 16, 0, 0); } while (0)
#define PG8_LDA(dst, b, h) do { _Pragma("unroll") for (int m = 0; m < 4; ++m) _Pragma("unroll") for (int k = 0; k < 2; ++k) dst[m][k] = *(const PG8_LAS bf16x8*)(lds + PG8_SA(b, h) + aoff + m * 2048 + k * 1024); } while (0)
#define PG8_LDB(dst, b, h) do { _Pragma("unroll") for (int n = 0; n < 2; ++n) _Pragma("unroll") for (int k = 0; k < 2; ++k) dst[n][k] = *(const PG8_LAS bf16x8*)(lds + PG8_SB(b, h) + boff + n * 2048 + k * 1024); } while (0)
#define PG8_MMA(ai, bj, At, Bt) do { __builtin_amdgcn_s_setprio(1); _Pragma("unroll") for (int m = 0; m < 4; ++m) _Pragma("unroll") for (int n = 0; n < 2; ++n) _Pragma("unroll") for (int k = 0; k < 2; ++k) \
        acc[ai][bj][m][n] = __builtin_amdgcn_mfma_f32_16x16x32_bf16(Bt[n][k], At[m][k], acc[ai][bj][m][n], 0, 0, 0); __builtin_amdgcn_s_setprio(0); } while (0)
#define PG8_WAIT_V(n) asm volatile("s_waitcnt vmcnt(" #n ")" ::: "memory")
#define PG8_WAIT_L(n) asm volatile("s_waitcnt lgkmcnt(" #n ")" ::: "memory")
#define PG8_BAR __builtin_amdgcn_s_barrier()
#define PG8_SCHED __builtin_amdgcn_sched_barrier(0)
    Unit cur, nxt; int ui = 0;
    if (!S.next(0, cur)) return;
    f32x4 acc[2][2][4][2];
#pragma unroll
    for (int a = 0; a < 2; ++a)
#pragma unroll
        for (int b = 0; b < 2; ++b)
#pragma unroll
            for (int m = 0; m < 4; ++m)
#pragma unroll
                for (int n = 0; n < 2; ++n) acc[a][b][m][n] = (f32x4){0.f, 0.f, 0.f, 0.f};
    bf16x8 At[4][2], B0[2][2], B1[2][2];
    const char* cA = (const char*)g.A + (size_t)cur.pm * tstep; const char* cB = (const char*)g.Bt + (size_t)cur.pn * tstep;
    S.a_ready(cur);
    if constexpr (SP2) {
        PG8_STAGE(PG8_SB(0, 0), cB, voffB); PG8_STAGE(PG8_SB(0, 1), cB + hstep, voffB); PG8_STAGE(PG8_SA(0, 0), cA, voffA); PG8_STAGE(PG8_SA(0, 1), cA + hstep, voffA);
        if (wr == 1) PG8_BAR;
        PG8_WAIT_V(2); PG8_BAR;
        PG8_STAGE(PG8_SB(1, 0), cB + kstep, voffB); PG8_STAGE(PG8_SA(1, 0), cA + kstep, voffA); PG8_STAGE(PG8_SB(1, 1), cB + hstep + kstep, voffB);
        PG8_WAIT_V(6); PG8_BAR;
    } else {
        PG8_STAGE(PG8_SB(0, 0), cB, voffB); PG8_STAGE(PG8_SA(0, 0), cA, voffA); PG8_STAGE(PG8_SB(0, 1), cB + hstep, voffB); PG8_STAGE(PG8_SA(0, 1), cA + hstep, voffA);
        if (wr == 1) PG8_BAR;
        PG8_WAIT_V(4); PG8_BAR;
        PG8_STAGE(PG8_SB(1, 0), cB + kstep, voffB); PG8_STAGE(PG8_SA(1, 0), cA + kstep, voffA); PG8_STAGE(PG8_SB(1, 1), cB + hstep + kstep, voffB);
        PG8_WAIT_V(6); PG8_BAR;
    }
    for (;;) {
        const bool has_next = S.next(ui + 1, nxt);
        const char* nA = has_next ? (const char*)g.A + (size_t)nxt.pm * tstep : cA; const char* nB = has_next ? (const char*)g.Bt + (size_t)nxt.pn * tstep : cB;
        for (int t = 0; t < nt; t += 2) {
            const bool last = (t == nt - 2);
            const char* a1 = cA + (size_t)(t + 1) * kstep;
            const char* a2 = last ? nA : cA + (size_t)(t + 2) * kstep; const char* b2 = last ? nB : cB + (size_t)(t + 2) * kstep;
            const char* a3 = a2 + kstep; const char* b3 = b2 + kstep;
            if (last && has_next) S.a_ready(nxt);
            if constexpr (SP2) {
            PG8_LDB(B0, 0, 0); PG8_LDB(B1, 0, 1); PG8_SCHED; PG8_LDA(At, 0, 0); PG8_STAGE(PG8_SA(1, 1), a1 + hstep, voffA);
            PG8_WAIT_V(8); PG8_WAIT_L(0); PG8_BAR; PG8_MMA(0, 0, At, B0); PG8_MMA(0, 1, At, B1); PG8_BAR; PG8_SCHED;
            PG8_LDA(At, 0, 1); PG8_STAGE(PG8_SB(0, 0), b2, voffB); PG8_STAGE(PG8_SB(0, 1), b2 + hstep, voffB); PG8_STAGE(PG8_SA(0, 0), a2, voffA);
            PG8_WAIT_V(8); PG8_WAIT_L(0); PG8_BAR; PG8_MMA(1, 0, At, B0); PG8_MMA(1, 1, At, B1); PG8_BAR; PG8_SCHED;
            PG8_LDB(B0, 1, 0); PG8_LDB(B1, 1, 1); PG8_SCHED; PG8_LDA(At, 1, 0); PG8_STAGE(PG8_SA(0, 1), a2 + hstep, voffA);
            PG8_WAIT_V(8); PG8_WAIT_L(0); PG8_BAR; PG8_MMA(0, 0, At, B0); PG8_MMA(0, 1, At, B1); PG8_BAR; PG8_SCHED;
            PG8_LDA(At, 1, 1); PG8_STAGE(PG8_SB(1, 0), b3, voffB); PG8_STAGE(PG8_SB(1, 1), b3 + hstep, voffB); PG8_STAGE(PG8_SA(1, 0), a3, voffA);
            PG8_WAIT_V(8); PG8_WAIT_L(0); PG8_BAR; PG8_MMA(1, 0, At, B0); PG8_MMA(1, 1, At, B1); PG8_BAR; PG8_SCHED;
            } else {
            PG8_LDB(B0, 0, 0); PG8_SCHED; PG8_LDA(At, 0, 0); PG8_STAGE(PG8_SA(1, 1), a1 + hstep, voffA);
            PG8_WAIT_L(8); PG8_BAR; PG8_WAIT_L(0); PG8_MMA(0, 0, At, B0); PG8_BAR; PG8_SCHED;
            PG8_LDB(B1, 0, 1); PG8_STAGE(PG8_SB(0, 0), b2, voffB);
            PG8_BAR; PG8_WAIT_L(0); PG8_MMA(0, 1, At, B1); PG8_BAR;
            PG8_LDA(At, 0, 1); PG8_STAGE(PG8_SA(0, 0), a2, voffA);
            PG8_BAR; PG8_WAIT_L(0); PG8_MMA(1, 0, At, B0); PG8_BAR; PG8_SCHED;
            PG8_STAGE(PG8_SB(0, 1), b2 + hstep, voffB);
            PG8_WAIT_V(6); PG8_BAR; PG8_MMA(1, 1, At, B1); PG8_BAR;
            PG8_LDB(B0, 1, 0); PG8_SCHED; PG8_LDA(At, 1, 0); PG8_STAGE(PG8_SA(0, 1), a2 + hstep, voffA);
            PG8_WAIT_L(8); PG8_BAR; PG8_WAIT_L(0); PG8_MMA(0, 0, At, B0); PG8_BAR; PG8_SCHED;
            PG8_LDB(B1, 1, 1); PG8_STAGE(PG8_SB(1, 0), b3, voffB);
            PG8_BAR; PG8_WAIT_L(0); PG8_MMA(0, 1, At, B1); PG8_BAR;
            PG8_LDA(At, 1, 1); PG8_STAGE(PG8_SA(1, 0), a3, voffA);
            PG8_BAR; PG8_WAIT_L(0); PG8_MMA(1, 0, At, B0); PG8_BAR; PG8_SCHED;
            PG8_STAGE(PG8_SB(1, 1), b3 + hstep, voffB);
            PG8_WAIT_V(6); PG8_BAR; PG8_MMA(1, 1, At, B1); PG8_BAR;
            }
        }
        if constexpr (ALIGN_EPI) { if (wr == 0) PG8_BAR; }
        if constexpr (!Epi::AFTER_DRAIN) { E(acc, cur, wr, wc, fr, fq); S.done(cur); }
        if (!has_next) break;
#pragma unroll
        for (int a = 0; a < 2; ++a)
#pragma unroll
            for (int b = 0; b < 2; ++b)
#pragma unroll
                for (int m = 0; m < 4; ++m)
#pragma unroll
                    for (int n = 0; n < 2; ++n) acc[a][b][m][n] = (f32x4){0.f, 0.f, 0.f, 0.f};
        cur = nxt; cA = nA; cB = nB; ++ui;
        if constexpr (ALIGN_EPI) { if (wr == 1) PG8_BAR; }
    }
    PG8_WAIT_V(0);
    if constexpr (!ALIGN_EPI) { if (wr == 0) PG8_BAR; }
    PG8_BAR;
    if constexpr (Epi::AFTER_DRAIN) { E.fused(acc, cur, wr, wc, fr, fq, lds, wid, lane); S.done(cur); }
#undef PG8_SA
#undef PG8_SB
#undef PG8_STAGE
#undef PG8_LDA
#undef PG8_LDB
#undef PG8_MMA
#undef PG8_WAIT_V
#undef PG8_WAIT_L
#undef PG8_BAR
#undef PG8_SCHED
}
}

#define GAS __attribute__((address_space(1)))
#define LAS __attribute__((address_space(3)))
typedef unsigned short bf16;
typedef unsigned v4u __attribute__((ext_vector_type(4)));
typedef unsigned v2u __attribute__((ext_vector_type(2)));
typedef float f32x4 __attribute__((ext_vector_type(4)));
typedef float f32x16 __attribute__((ext_vector_type(16)));
typedef short bf16x8 __attribute__((ext_vector_type(8)));
typedef short s16x4 __attribute__((ext_vector_type(4)));
constexpr int NWAVES = 8;
constexpr float LN_EPS = 1e-5f;
constexpr float DN_ALPHA = 1.189207115002721f;
constexpr int LDS_BYTES = 147456;
#define LDS_WAIT() asm volatile("s_waitcnt lgkmcnt(0)" ::: "memory")

constexpr size_t MiB = 1u << 20;
constexpr size_t WS_W_IN = 2 * MiB, WS_W_SC = 12 * MiB, WS_W_OUT = 14 * MiB, WS_W_MI = 16 * MiB, WS_W_MO = 24 * MiB;
constexpr size_t WS_XB = 32 * MiB;
constexpr size_t WS_QKV = 96 * MiB;
constexpr size_t WS_GATES = 288 * MiB;
constexpr size_t WS_O2 = 416 * MiB;
constexpr size_t WS_T = 96 * MiB;
constexpr size_t WS_MERGED = 224 * MiB;
constexpr size_t WS_H = 96 * MiB;
constexpr size_t WS_END = 480 * MiB;
constexpr size_t WS_CTL = 0, CTL_ZERO_BYTES = 16384;
constexpr int BAR_LDS_OFF = 131072 + 512;

__device__ __forceinline__ float wave_sum(float v) {
#pragma unroll
    for (int o = 1; o < 64; o <<= 1) v += __shfl_xor(v, o);
    return v;
}
__device__ __forceinline__ unsigned pk2(float lo, float hi) { return pg8::cvt_pk_bf16(lo, hi); }

__device__ __forceinline__ void p0_transpose_item(const float* W, int K, int N, bf16* WT, int row_off, LAS float* scr, int item, int lane) {
    const int nblk = N / 32, kb = item / nblk, nb = item % nblk, k0 = 64 * kb, n0 = 32 * nb;
#pragma unroll 8
    for (int i = 0; i < 32; ++i) { const int kk = 2 * i + (lane >> 5); scr[kk * 33 + (lane & 31)] = W[(size_t)(k0 + kk) * N + n0 + (lane & 31)]; }
    LDS_WAIT(); asm volatile("" ::: "memory");
    const int c = lane & 7;
#pragma unroll
    for (int j = 0; j < 4; ++j) { const int n = (lane >> 3) + 8 * j; const LAS float* s = scr + (8 * c) * 33 + n;
        v4u o; o.x = pk2(s[0 * 33], s[1 * 33]); o.y = pk2(s[2 * 33], s[3 * 33]); o.z = pk2(s[4 * 33], s[5 * 33]); o.w = pk2(s[6 * 33], s[7 * 33]);
        *(GAS v4u*)(WT + (size_t)(row_off + n0 + n) * K + k0 + 8 * c) = o; }
    LDS_WAIT(); asm volatile("" ::: "memory");
}

template <int NR> __device__ __forceinline__ void rows_to_bf16(const float* x, bf16* o, int m0, int mstride, int lane) {
    f32x4 v[NR][4];
#pragma unroll
    for (int k = 0; k < NR; ++k)
#pragma unroll
        for (int j = 0; j < 4; ++j) v[k][j] = __builtin_nontemporal_load((const f32x4*)(x + (size_t)(m0 + k * mstride) * 1024) + lane + 64 * j);
#pragma unroll
    for (int k = 0; k < NR; ++k)
#pragma unroll
        for (int j = 0; j < 4; ++j) { v2u w; w.x = pk2(v[k][j][0], v[k][j][1]); w.y = pk2(v[k][j][2], v[k][j][3]); ((v2u*)(o + (size_t)(m0 + k * mstride) * 1024))[lane + 64 * j] = w; }
}
template <int NR, bool BF> __device__ __forceinline__ void ln_rows(float* base, bf16* bbase, const float* g, const float* bta, int m0, int mstride, int lane) {
    f32x4 v[NR][4]; float s[NR], s2[NR];
#pragma unroll
    for (int k = 0; k < NR; ++k)
#pragma unroll
        for (int j = 0; j < 4; ++j) v[k][j] = ((const f32x4*)(base + (size_t)(m0 + k * mstride) * 1024))[lane + 64 * j];
#pragma unroll
    for (int k = 0; k < NR; ++k) { s[k] = 0.f;
#pragma unroll
        for (int j = 0; j < 4; ++j) s[k] += (v[k][j][0] + v[k][j][1]) + (v[k][j][2] + v[k][j][3]); }
#pragma unroll
    for (int o = 1; o < 64; o <<= 1)
#pragma unroll
        for (int k = 0; k < NR; ++k) s[k] += __shfl_xor(s[k], o);
#pragma unroll
    for (int k = 0; k < NR; ++k) { const float mean = s[k] * (1.f / 1024.f); s2[k] = 0.f;
#pragma unroll
        for (int j = 0; j < 4; ++j) { v[k][j] = v[k][j] - mean; s2[k] += (v[k][j][0] * v[k][j][0] + v[k][j][1] * v[k][j][1]) + (v[k][j][2] * v[k][j][2] + v[k][j][3] * v[k][j][3]); } }
#pragma unroll
    for (int o = 1; o < 64; o <<= 1)
#pragma unroll
        for (int k = 0; k < NR; ++k) s2[k] += __shfl_xor(s2[k], o);
#pragma unroll
    for (int j = 0; j < 4; ++j) { const f32x4 gg = ((const f32x4*)g)[lane + 64 * j], bb = ((const f32x4*)bta)[lane + 64 * j];
#pragma unroll
        for (int k = 0; k < NR; ++k) { const float rstd = 1.f / sqrtf(s2[k] * (1.f / 1024.f) + LN_EPS); const f32x4 y = v[k][j] * rstd * gg + bb;
            ((f32x4*)(base + (size_t)(m0 + k * mstride) * 1024))[lane + 64 * j] = y;
            if (BF) { v2u w; w.x = pk2(y[0], y[1]); w.y = pk2(y[2], y[3]); ((v2u*)(bbase + (size_t)(m0 + k * mstride) * 1024))[lane + 64 * j] = w; } } }
}

#define XB_TMO      128
#define XB_XCNT(j)  (256  + 64 * (j))
#define XB_XSUB(j)  (1280 + 64 * (j))
#define XB_XGEN(j)  (2304 + 64 * (j))
#define XB_TOP      3328
#define XB_TOPGEN   3392
#define XCD_BAR_WORDS 3456
#define XB_SPIN_CAP (1u << 18)

__device__ __forceinline__ unsigned xb_ld(unsigned* p)              { return __hip_atomic_load(p, __ATOMIC_RELAXED, __HIP_MEMORY_SCOPE_AGENT); }
__device__ __forceinline__ unsigned xb_add(unsigned* p, unsigned v) { return __hip_atomic_fetch_add(p, v, __ATOMIC_RELAXED, __HIP_MEMORY_SCOPE_AGENT); }
__device__ __forceinline__ unsigned xb_xcc_id() { return (unsigned)__builtin_amdgcn_s_getreg((3 << 11) | 20) & 0xFu; }
#define XB_SPIN(cond, bar) do { unsigned _sp = 0; while (cond) { __builtin_amdgcn_s_sleep(1); \
    if ((++_sp & 255u) == 0u) { if (xb_ld(&(bar)[XB_TMO])) break; if (_sp > XB_SPIN_CAP) { atomicAdd(&(bar)[XB_TMO], 1u); break; } } } } while (0)

struct XcdBarrier {
    unsigned* bar; unsigned x;
    volatile LAS unsigned* st;
};

__device__ __forceinline__ XcdBarrier xcd_barrier_post(unsigned* bar, volatile LAS unsigned* st) {
    XcdBarrier b; b.bar = bar; b.x = xb_xcc_id(); b.st = st;
    if (threadIdx.x == 0) (void)xb_add(&bar[XB_XCNT(b.x)], 1u);
    return b;
}
__device__ __forceinline__ void xcd_barrier_complete(unsigned* bar, unsigned x, unsigned& nloc, unsigned& nx) {
    const unsigned G = gridDim.x * gridDim.y * gridDim.z;
    unsigned sum, cnt, mine, sp = 0u;
    for (;;) {
        sum = 0u; cnt = 0u; mine = 0u;
#pragma unroll
        for (unsigned j = 0; j < 16; ++j) { const unsigned c = xb_ld(&bar[XB_XCNT(j)]); sum += c; cnt += (c > 0u) ? 1u : 0u; mine = (j == x) ? c : mine; }
        if (sum == G) break;
        __builtin_amdgcn_s_sleep(1);
        if ((++sp & 255u) == 0u) { if (xb_ld(&bar[XB_TMO])) break; if (sp > XB_SPIN_CAP) { atomicAdd(&bar[XB_TMO], 1u); break; } }
    }
    nloc = mine > 0u ? mine : 1u; nx = cnt > 0u ? cnt : 1u;
}

__device__ __forceinline__ void xcd_barrier(const XcdBarrier& b) {
    asm volatile("s_waitcnt vmcnt(0)" ::: "memory");
    __syncthreads();
    if (threadIdx.x == 0) {
        unsigned* bar = b.bar;
        __builtin_amdgcn_s_waitcnt(0);
        unsigned nloc = b.st[0], nx = b.st[1];
        if (nloc == 0u) { xcd_barrier_complete(bar, b.x, nloc, nx); b.st[0] = nloc; b.st[1] = nx; }
        const unsigned old = xb_add(&bar[XB_XSUB(b.x)], 1u);
        const unsigned gen = old / nloc;
        if (old + 1u == (gen + 1u) * nloc) {
            __builtin_amdgcn_fence(__ATOMIC_RELEASE, "agent");
            asm volatile("s_waitcnt vmcnt(0)" ::: "memory");
            const unsigned og = xb_add(&bar[XB_TOP], 1u);
            const unsigned tg = og / nx;
            if (og + 1u == (tg + 1u) * nx) xb_add(&bar[XB_TOPGEN], 1u);
            else XB_SPIN(xb_ld(&bar[XB_TOPGEN]) == tg, bar);
            __builtin_amdgcn_fence(__ATOMIC_ACQUIRE, "agent");
            xb_add(&bar[XB_XGEN(b.x)], 1u);
            asm volatile("s_waitcnt vmcnt(0)" ::: "memory");
        } else {
            XB_SPIN(xb_ld(&bar[XB_XGEN(b.x)]) == gen, bar);
            __builtin_amdgcn_fence(__ATOMIC_ACQUIRE, "agent");
            asm volatile("s_waitcnt vmcnt(0)" ::: "memory");
        }
    }
    __syncthreads();
}

#define MFMA32(a, b, c) __builtin_amdgcn_mfma_f32_32x32x16_bf16((a), (b), (c), 0, 0, 0)
__device__ __forceinline__ int crow(int reg, int h) { return (reg & 3) + 8 * (reg >> 2) + 4 * h; }
__device__ __forceinline__ void load_frag4(bf16x8 (&f)[4], const bf16* p  , int lane) {
    const bf16x8* q = (const bf16x8*)p + lane;
#pragma unroll
    for (int s = 0; s < 4; ++s) f[s] = q[64 * s];
}
__device__ __forceinline__ void load_vt(bf16x8 (&v)[2][2], const bf16* p  , int lane) {
    const bf16x8* q = (const bf16x8*)p + lane;
#pragma unroll
    for (int db = 0; db < 2; ++db)
#pragma unroll
        for (int s = 0; s < 2; ++s) v[db][s] = q[64 * (db * 2 + s)];
}
__device__ __forceinline__ bf16x8 pack8(const float (&p)[16], int s) {
    v4u w; w.x = pk2(p[8 * s], p[8 * s + 1]); w.y = pk2(p[8 * s + 2], p[8 * s + 3]); w.z = pk2(p[8 * s + 4], p[8 * s + 5]); w.w = pk2(p[8 * s + 6], p[8 * s + 7]);
    return __builtin_bit_cast(bf16x8, w);
}
__device__ __forceinline__ void store_o(bf16* orow  , const f32x16& o0, const f32x16& o1, float sc, int hi) {
#pragma unroll
    for (int g = 0; g < 4; ++g) { v2u w0, w1;
        w0.x = pk2(o0[4 * g] * sc, o0[4 * g + 1] * sc); w0.y = pk2(o0[4 * g + 2] * sc, o0[4 * g + 3] * sc);
        w1.x = pk2(o1[4 * g] * sc, o1[4 * g + 1] * sc); w1.y = pk2(o1[4 * g + 2] * sc, o1[4 * g + 3] * sc);
        *(v2u*)(orow + 8 * g + 4 * hi) = w0; *(v2u*)(orow + 32 + 8 * g + 4 * hi) = w1; }
}

__device__ __forceinline__ void sb_unit(const bf16* Q, const bf16* K, const bf16* VT, bf16* O, int bh, int qb, int lane) {
    const int r = lane & 31, hi = lane >> 5, b = bh >> 3, h = bh & 7;
    const size_t rowbase = (size_t)b * SEQL;
    const bf16* Kh = K + (size_t)bh * 128 * 2048;
    const bf16* VTh = VT + (size_t)bh * 128 * 2048;
    bf16x8 qf[4], kf[4];
    load_frag4(qf, Q + ((size_t)bh * 128 + qb) * 2048, lane);
    load_frag4(kf, Kh + (size_t)qb * 2048, lane);
    f32x16 o0, o1;
#pragma unroll
    for (int i = 0; i < 16; ++i) { o0[i] = 0.f; o1[i] = 0.f; }
    float R = 0.f;
    for (int kb = qb; kb >= 0; --kb) {
        bf16x8 vf[2][2], kn[4];
        load_vt(vf, VTh + (size_t)kb * 2048, lane);
        load_frag4(kn, Kh + (size_t)(kb > 0 ? kb - 1 : 0) * 2048, lane);
        f32x16 z;
#pragma unroll
        for (int i = 0; i < 16; ++i) z[i] = 0.f;
#pragma unroll
        for (int s = 0; s < 4; ++s) z = MFMA32(kf[s], qf[s], z);
        const bool diag = (kb == qb);
        float lk[16], ls[16], G[4];
#pragma unroll
        for (int g = 0; g < 4; ++g) G[g] = 0.f;
#pragma unroll
        for (int i = 0; i < 16; ++i) {
            const float zi = z[i];
            const bool valid = !diag || (crow(i, hi) < r);
            const float sp = fmaxf(zi, 0.f) + __logf(1.0f + __expf(-fabsf(zi)));
            lk[i] = valid ? -sp : 0.f;
            ls[i] = valid ? (zi - sp) : -INFINITY;
            G[i >> 2] += lk[i];
        }
        float Hh[4], A[4];
#pragma unroll
        for (int g = 0; g < 4; ++g) Hh[g] = __shfl_xor(G[g], 32);
        float run = 0.f;
#pragma unroll
        for (int g = 3; g >= 0; --g) { A[g] = run + (hi ? 0.f : Hh[g]); run += G[g] + Hh[g]; }
        float p[16];
#pragma unroll
        for (int g = 0; g < 4; ++g) { float e = R + A[g];
#pragma unroll
            for (int j = 3; j >= 0; --j) { p[4 * g + j] = __expf(ls[4 * g + j] + e); e += lk[4 * g + j]; } }
        R += run;
        const bf16x8 p0 = pack8(p, 0), p1 = pack8(p, 1);
        o0 = MFMA32(vf[0][0], p0, o0); o0 = MFMA32(vf[0][1], p1, o0);
        o1 = MFMA32(vf[1][0], p0, o1); o1 = MFMA32(vf[1][1], p1, o1);
#pragma unroll
        for (int s = 0; s < 4; ++s) kf[s] = kn[s];
        if (__all(R < -106.0f)) break;
    }
    store_o(O + (rowbase + qb * 32 + r) * 512 + h * 64, o0, o1, 1.0f, hi);
}

__device__ __forceinline__ void ca_unit(const bf16* Q, const bf16* K, const bf16* VT, bf16* O, const LAS float* tab, int bh, int c, int hf, int lane) {
    const int r = lane & 31, hi = lane >> 5, b = bh >> 3, h = bh & 7;
    const size_t rowbase = (size_t)b * SEQL;
    const bf16* Kh = K + (size_t)bh * 128 * 2048;
    const bf16* VTh = VT + (size_t)bh * 128 * 2048;
    const int t0 = c * 64 + hf * 32;
    const int kb0 = (c > 8 ? c - 8 : 0) * 2, kb1 = (c + 1) * 2;
    bf16x8 qf[4], kf[4];
    load_frag4(qf, Q + ((size_t)bh * 128 + (t0 >> 5)) * 2048, lane);
    load_frag4(kf, Kh + (size_t)kb0 * 2048, lane);
    f32x16 o0, o1;
#pragma unroll
    for (int i = 0; i < 16; ++i) { o0[i] = 0.f; o1[i] = 0.f; }
    float mrun = -INFINITY, l = 0.f;
    const float bias_far = tab[512];
    for (int kb = kb0; kb < kb1; ++kb) {
        bf16x8 vf[2][2], kn[4];
        load_vt(vf, VTh + (size_t)kb * 2048, lane);
        load_frag4(kn, Kh + (size_t)(kb + 1 < kb1 ? kb + 1 : kb) * 2048, lane);
        f32x16 z;
#pragma unroll
        for (int i = 0; i < 16; ++i) z[i] = 0.f;
#pragma unroll
        for (int s = 0; s < 4; ++s) z = MFMA32(kf[s], qf[s], z);
        const int k0 = kb * 32;
        float zz[16];
        if (t0 - (k0 + 31) >= 256) {
#pragma unroll
            for (int i = 0; i < 16; ++i) zz[i] = z[i] + bias_far;
        } else {
            const int d0 = t0 + r - k0 + 256;
#pragma unroll
            for (int i = 0; i < 16; ++i) { int idx = d0 - crow(i, hi); idx = idx < 0 ? 0 : (idx > 512 ? 512 : idx); zz[i] = z[i] + tab[idx]; }
        }
        float mx = zz[0];
#pragma unroll
        for (int i = 1; i < 16; ++i) mx = fmaxf(mx, zz[i]);
        mx = fmaxf(mx, __shfl_xor(mx, 32));
        const float mnew = fmaxf(mrun, mx);
        const float alpha = __expf(mrun - mnew);
        float p[16]; float ps = 0.f;
#pragma unroll
        for (int i = 0; i < 16; ++i) { p[i] = __expf(zz[i] - mnew); ps += p[i]; }
        l = l * alpha + ps; mrun = mnew;
#pragma unroll
        for (int i = 0; i < 16; ++i) { o0[i] *= alpha; o1[i] *= alpha; }
        const bf16x8 p0 = pack8(p, 0), p1 = pack8(p, 1);
        o0 = MFMA32(vf[0][0], p0, o0); o0 = MFMA32(vf[0][1], p1, o0);
        o1 = MFMA32(vf[1][0], p0, o1); o1 = MFMA32(vf[1][1], p1, o1);
#pragma unroll
        for (int s = 0; s < 4; ++s) kf[s] = kn[s];
    }
    l += __shfl_xor(l, 32);
    store_o(O + (rowbase + t0 + r) * 512 + h * 64, o0, o1, 1.0f / l, hi);
}

struct Args { const float* x; const float* w_in; const float* b_gate; const float* w_sb; const float* w_ca; const float* rel_bias; const float* w_out; const float* ln1_g; const float* ln1_b;
              const float* w_mi; const float* w_mo; const float* ln2_g; const float* ln2_b; float* out; unsigned char* ws; };

__global__ void __launch_bounds__(NWAVES * 64, 2) mk_fwd(Args a) {
    extern __shared__ __attribute__((aligned(16))) unsigned char lds_raw[];
    LAS unsigned char* lds = (LAS unsigned char*)lds_raw;
    cg::grid_group grid = cg::this_grid();
    const int tid = threadIdx.x, lane = tid & 63, wave = __builtin_amdgcn_readfirstlane(tid >> 6);
    const int G = gridDim.x, bx = blockIdx.x;
    const int vcu = (G % 8 == 0) ? (bx % 8) * (G / 8) + bx / 8 : bx;
    const int gw = vcu * NWAVES + wave, NGW = G * NWAVES;
    unsigned char* ws = a.ws;
    bf16* W_IN = (bf16*)(ws + WS_W_IN); bf16* W_SC = (bf16*)(ws + WS_W_SC); bf16* W_OUT = (bf16*)(ws + WS_W_OUT); bf16* W_MI = (bf16*)(ws + WS_W_MI); bf16* W_MO = (bf16*)(ws + WS_W_MO);
    bf16* XB = (bf16*)(ws + WS_XB); bf16* QKV = (bf16*)(ws + WS_QKV); bf16* GATES = (bf16*)(ws + WS_GATES); bf16* O2 = (bf16*)(ws + WS_O2);
    float* T = (float*)(ws + WS_T); bf16* MERGED = (bf16*)(ws + WS_MERGED); bf16* HB = (bf16*)(ws + WS_H);
    constexpr size_t QSZ = (size_t)MTOK * 512;
    volatile LAS unsigned* bst = (volatile LAS unsigned*)(lds + BAR_LDS_OFF);
    if (tid < 4) bst[tid] = 0u;
    __syncthreads();
    const XcdBarrier bar = xcd_barrier_post((unsigned*)(ws + WS_CTL), bst);

    {
        LAS float* scr = (LAS float*)(lds + wave * 16384);
        constexpr int I_IN = (DMODEL / 64) * (NINC / 32), I_SB = (WIDTH / 64) * (DMODEL / 32), I_OUT = (DMODEL / 64) * (DMODEL / 32), I_MI = (DMODEL / 64) * (DFF / 32), I_MO = (DFF / 64) * (DMODEL / 32);
        constexpr int NITEMS = I_IN + 2 * I_SB + I_OUT + I_MI + I_MO;
        for (int it = gw; it < NITEMS; it += NGW) {
            int q = it;
            if (q < I_IN) { p0_transpose_item(a.w_in, DMODEL, NINC, W_IN, 0, scr, q, lane); continue; } q -= I_IN;
            if (q < I_SB) { p0_transpose_item(a.w_sb, WIDTH, DMODEL, W_SC, 0, scr, q, lane); continue; } q -= I_SB;
            if (q < I_SB) { p0_transpose_item(a.w_ca, WIDTH, DMODEL, W_SC, DMODEL, scr, q, lane); continue; } q -= I_SB;
            if (q < I_OUT) { p0_transpose_item(a.w_out, DMODEL, DMODEL, W_OUT, 0, scr, q, lane); continue; } q -= I_OUT;
            if (q < I_MI) { p0_transpose_item(a.w_mi, DMODEL, DFF, W_MI, 0, scr, q, lane); continue; } q -= I_MI;
            p0_transpose_item(a.w_mo, DFF, DMODEL, W_MO, 0, scr, q, lane);
        }
        for (int m = gw; m < MTOK; m += 4 * NGW) rows_to_bf16<4>(a.x, XB, m, NGW, lane);
    }
    grid.sync();

    {
        pg8::Gemm g{XB, W_IN, MTOK, NINC, DMODEL}; pg8::StaticOrder S; S.init(MTOK, NINC, G, bx);
        pg8::EpiIn E{QKV, GATES, a.b_gate};
        pg8::gemm_phase<pg8::EpiIn, pg8::StaticOrder, true, true>(lds, g, S, E);
    }
    xcd_barrier(bar);

    {
        LAS float* tab = (LAS float*)lds;
        for (int i = tid; i < NHEADS * 513; i += NWAVES * 64) tab[i] = a.rel_bias[i];
        __syncthreads();
        for (int u = gw; u < 16384; u += NGW) {
            if (u < 8192) { const int bh = u >> 7, qb = u & 127; sb_unit(QKV, QKV + QSZ, QKV + 2 * QSZ, O2, bh, qb, lane); }
            else { const int v = u - 8192, bh = v >> 7, c = (v & 127) >> 1, hf = v & 1; ca_unit(QKV + 3 * QSZ, QKV + 4 * QSZ, QKV + 5 * QSZ, O2 + QSZ, tab + (bh & 7) * 513, bh, c, hf, lane); }
        }
        __syncthreads();
    }
    xcd_barrier(bar);

    {
        pg8::Gemm g{O2, W_SC, 2 * MTOK, 2 * DMODEL, WIDTH}; pg8::MergeOrder S; S.so.init(MTOK, DMODEL, G, bx);
        pg8::EpiMerge E{GATES, T, MERGED};
        pg8::gemm_phase<pg8::EpiMerge, pg8::MergeOrder, true, true>(lds, g, S, E);
    }
    xcd_barrier(bar);

    {
        pg8::Gemm g{MERGED, W_OUT, MTOK, DMODEL, DMODEL}; pg8::StaticOrder S; S.init(MTOK, DMODEL, G, bx);
        pg8::EpiRes E{a.x, a.out, DN_ALPHA};
        pg8::gemm_phase<pg8::EpiRes, pg8::StaticOrder, true, true>(lds, g, S, E);
    }
    xcd_barrier(bar);

    for (int m = gw; m < MTOK; m += 4 * NGW) ln_rows<4, true>(a.out, XB, a.ln1_g, a.ln1_b, m, NGW, lane);
    xcd_barrier(bar);

    {
        pg8::Gemm g{XB, W_MI, MTOK, DFF, DMODEL}; pg8::StaticOrder S; S.init(MTOK, DFF, G, bx);
        pg8::EpiRelu2 E{HB};
        pg8::gemm_phase<pg8::EpiRelu2, pg8::StaticOrder, true, true>(lds, g, S, E);
    }
    xcd_barrier(bar);

    {
        pg8::Gemm g{HB, W_MO, MTOK, DMODEL, DFF}; pg8::StaticOrder S; S.init(MTOK, DMODEL, G, bx);
        pg8::EpiRes E{a.out, a.out, DN_ALPHA};
        pg8::gemm_phase<pg8::EpiRes, pg8::StaticOrder, true, true>(lds, g, S, E);
    }
    xcd_barrier(bar);

    for (int m = gw; m < MTOK; m += 4 * NGW) ln_rows<4, false>(a.out, nullptr, a.ln2_g, a.ln2_b, m, NGW, lane);
}

extern "C" void kernel_launch(void* const* d_in, const int* in_sizes, int n_in, void* d_out, int out_size, void* d_ws, size_t ws_size, hipStream_t stream) {
    static int grid = 0;
    if (grid == 0) {
        if (n_in != 13 || in_sizes[0] != MTOK * DMODEL || out_size != MTOK * DMODEL || ws_size < WS_END) { fprintf(stderr, "kernel_launch: unexpected shapes (n_in %d, in0 %d, out %d, ws %zu); nothing launched\n", n_in, n_in > 0 ? in_sizes[0] : -1, out_size, ws_size); grid = -1; return; }
        int dev = 0, cus = 0, per_cu = 0;
        if (hipGetDevice(&dev) != hipSuccess || hipDeviceGetAttribute(&cus, hipDeviceAttributeMultiprocessorCount, dev) != hipSuccess) { fprintf(stderr, "kernel_launch: device query failed\n"); grid = -1; return; }
        if (hipFuncSetAttribute((const void*)mk_fwd, hipFuncAttributeMaxDynamicSharedMemorySize, LDS_BYTES) != hipSuccess) { fprintf(stderr, "kernel_launch: hipFuncSetAttribute failed\n"); grid = -1; return; }
        if (hipOccupancyMaxActiveBlocksPerMultiprocessor(&per_cu, (const void*)mk_fwd, NWAVES * 64, LDS_BYTES) != hipSuccess || per_cu < 1) { fprintf(stderr, "kernel_launch: occupancy query says %d blocks per CU\n", per_cu); per_cu = 1; }
        (void)hipGetLastError();
        if (cus != 256) { fprintf(stderr, "kernel_launch: built for a 256-CU device, found %d CUs; nothing launched\n", cus); grid = -1; return; }
        grid = cus * 1;
    }
    if (grid < 0) return;
    if (hipMemsetAsync((char*)d_ws + WS_CTL, 0, CTL_ZERO_BYTES, stream) != hipSuccess) { fprintf(stderr, "kernel_launch: memset failed\n"); return; }
    Args a{};
    a.x = (const float*)d_in[0]; a.w_in = (const float*)d_in[1]; a.b_gate = (const float*)d_in[2]; a.w_sb = (const float*)d_in[3]; a.w_ca = (const float*)d_in[4]; a.rel_bias = (const float*)d_in[5];
    a.w_out = (const float*)d_in[6]; a.ln1_g = (const float*)d_in[7]; a.ln1_b = (const float*)d_in[8]; a.w_mi = (const float*)d_in[9]; a.w_mo = (const float*)d_in[10]; a.ln2_g = (const float*)d_in[11]; a.ln2_b = (const float*)d_in[12];
    a.out = (float*)d_out; a.ws = (unsigned char*)d_ws;
    void* args[] = {&a};
    const hipError_t e = hipLaunchCooperativeKernel((const void*)mk_fwd, dim3(grid), dim3(NWAVES * 64), args, LDS_BYTES, stream);
    if (e != hipSuccess) fprintf(stderr, "kernel_launch: cooperative launch failed: %s (grid %d)\n", hipGetErrorString(e), grid);
}
```
